# Optimizing an MI355X kernel written in HIP

```python
import math
import jax, jax.numpy as jnp
from jax import lax
import numpy as np

D_MODEL = 2048
BATCH = 4
SEQ = 2048
DEPTH = 1

CHUNK = 64
Q_BLOCK = 128
NORM_EPS = 1e-6
SUBLN_EPS = 1e-5
DA_HEADS = 8
DA_QK_DIM = 64
DA_V_DIM = 2 * DA_QK_DIM
DA_WIDTH = DA_HEADS * DA_V_DIM
SB_HEADS = 16
SB_HEAD_DIM = 64
SB_WIDTH = SB_HEADS * SB_HEAD_DIM
REL_BUCKETS = 32
REL_MAX_DIST = 128
D_FF = 5632
IN_SIZES = [DA_HEADS * 2 * DA_QK_DIM, DA_HEADS * 2 * DA_QK_DIM, DA_WIDTH,
            SB_WIDTH, SB_WIDTH, SB_WIDTH, D_MODEL, D_MODEL]
IN_TOTAL = int(sum(IN_SIZES))
IN_SPLITS = [int(v) for v in np.cumsum(IN_SIZES)[:-1]]

kernel_name = "hybrid_diff_stickbreak_macaron_block"


def rms_norm(x, g, eps=NORM_EPS):
    xf = x.astype(jnp.float32)
    y = xf * lax.rsqrt(jnp.mean(xf * xf, axis=-1, keepdims=True) + eps)
    return (y * g.astype(jnp.float32)).astype(x.dtype)


def swiglu(x, w_gu, w_down):
    gate, up = jnp.split(x @ w_gu, 2, axis=-1)
    return (jax.nn.silu(gate) * up) @ w_down


def rel_bucket(rel):
    nb = REL_BUCKETS // 2
    max_exact = nb // 2
    ret = jnp.where(rel > 0, nb, 0)
    n = jnp.abs(rel)
    nf = jnp.maximum(n, 1).astype(jnp.float32)
    large = max_exact + (jnp.log(nf / max_exact) / math.log(REL_MAX_DIST / max_exact)
                         * (nb - max_exact)).astype(jnp.int32)
    large = jnp.minimum(large, nb - 1)
    return ret + jnp.where(n < max_exact, n, large)


def diff_attention(q, k, v, rel_bias, lam_q1, lam_k1, lam_q2, lam_k2, subln_g, lambda_init):
    B, S, _ = q.shape
    nblk = S // Q_BLOCK
    scale = 1.0 / math.sqrt(DA_QK_DIM)
    k = k.reshape(B, S, DA_HEADS, 2, DA_QK_DIM).transpose(0, 2, 3, 1, 4)
    v = v.reshape(B, S, DA_HEADS, DA_V_DIM).transpose(0, 2, 1, 3)
    q_blocks = q.reshape(B, nblk, Q_BLOCK, DA_HEADS, 2, DA_QK_DIM).transpose(1, 0, 3, 4, 2, 5)
    lam = (jnp.exp(jnp.sum(lam_q1.astype(jnp.float32) * lam_k1.astype(jnp.float32)))
           - jnp.exp(jnp.sum(lam_q2.astype(jnp.float32) * lam_k2.astype(jnp.float32)))
           + lambda_init)
    k_pos = jnp.arange(S)

    def block(args):
        blk, qb = args
        q_pos = blk * Q_BLOCK + jnp.arange(Q_BLOCK)
        s = jnp.einsum('bhmqd,bhmkd->bhmqk', qb, k).astype(jnp.float32) * scale
        bias = rel_bias[rel_bucket(k_pos[None, :] - q_pos[:, None])].astype(jnp.float32)
        bias = bias.reshape(Q_BLOCK, S, DA_HEADS, 2).transpose(2, 3, 0, 1)
        allowed = (k_pos[None, :] // CHUNK) <= (q_pos[:, None] // CHUNK)
        p = jax.nn.softmax(jnp.where(allowed, s + bias, -jnp.inf), axis=-1)
        attn = p[:, :, 0] - lam * p[:, :, 1]
        return jnp.einsum('bhqk,bhkv->bhqv', attn.astype(v.dtype), v)

    o = lax.map(block, (jnp.arange(nblk), q_blocks))
    o = rms_norm(o, subln_g, SUBLN_EPS) * (1.0 - lambda_init)
    return o.transpose(1, 0, 3, 2, 4).reshape(B, S, DA_WIDTH)


def stick_breaking_attention(q, k, v):
    B, S, _ = q.shape
    nblk = S // Q_BLOCK
    scale = 1.0 / math.sqrt(SB_HEAD_DIM)
    k = k.reshape(B, S, SB_HEADS, SB_HEAD_DIM).transpose(0, 2, 1, 3)
    v = v.reshape(B, S, SB_HEADS, SB_HEAD_DIM).transpose(0, 2, 1, 3)
    q_blocks = q.reshape(B, nblk, Q_BLOCK, SB_HEADS, SB_HEAD_DIM).transpose(1, 0, 3, 2, 4)
    k_pos = jnp.arange(S)

    def block(args):
        blk, qb = args
        q_pos = blk * Q_BLOCK + jnp.arange(Q_BLOCK)
        z = jnp.einsum('bhqd,bhkd->bhqk', qb, k).astype(jnp.float32) * scale
        strict = k_pos[None, :] < q_pos[:, None]
        log_keep = jnp.where(strict, jax.nn.log_sigmoid(-z), 0.0)
        log_between = lax.cumsum(log_keep, axis=3, reverse=True) - log_keep
        w = jnp.where(strict, jnp.exp(jax.nn.log_sigmoid(z) + log_between), 0.0)
        return jnp.einsum('bhqk,bhkd->bhqd', w.astype(v.dtype), v)

    o = lax.map(block, (jnp.arange(nblk), q_blocks))
    return o.transpose(1, 0, 3, 2, 4).reshape(B, S, SB_WIDTH)


def setup_inputs(seed: int = 0) -> dict:
    key = jax.random.key(seed)
    ks = jax.random.split(key, 24)
    f32 = jnp.float32

    def w(k, shape, fan_in):
        return jax.random.normal(k, shape, f32) * (fan_in ** -0.5)

    def gain(k, shape):
        return 1.0 + 0.02 * jax.random.normal(k, shape, f32)

    L = DEPTH
    return {
        "x": jax.random.normal(ks[0], (BATCH, SEQ, D_MODEL), f32),
        "rel_bias": 0.5 * jax.random.normal(ks[1], (REL_BUCKETS, 2 * DA_HEADS), f32),
        "ln_ffn1": gain(ks[2], (L, D_MODEL)),
        "w_ffn1_gu": w(ks[3], (L, D_MODEL, 2 * D_FF), D_MODEL),
        "w_ffn1_down": w(ks[4], (L, D_FF, D_MODEL), D_FF),
        "ln_mix": gain(ks[5], (L, D_MODEL)),
        "w_in": w(ks[6], (L, D_MODEL, IN_TOTAL), D_MODEL),
        "lambda_q1": 0.1 * jax.random.normal(ks[7], (L, DA_QK_DIM), f32),
        "lambda_k1": 0.1 * jax.random.normal(ks[8], (L, DA_QK_DIM), f32),
        "lambda_q2": 0.1 * jax.random.normal(ks[9], (L, DA_QK_DIM), f32),
        "lambda_k2": 0.1 * jax.random.normal(ks[10], (L, DA_QK_DIM), f32),
        "da_subln": gain(ks[11], (L, DA_V_DIM)),
        "w_branch_a": w(ks[12], (L, DA_WIDTH, D_MODEL), DA_WIDTH),
        "w_branch_b": w(ks[13], (L, SB_WIDTH, D_MODEL), SB_WIDTH),
        "w_out": w(ks[14], (L, D_MODEL, D_MODEL), D_MODEL),
        "ln_ffn2": gain(ks[15], (L, D_MODEL)),
        "w_ffn2_gu": w(ks[16], (L, D_MODEL, 2 * D_FF), D_MODEL),
        "w_ffn2_down": w(ks[17], (L, D_FF, D_MODEL), D_FF),
        "ln_final": gain(ks[18], (D_MODEL,)),
    }


def reference(x, rel_bias, ln_ffn1, w_ffn1_gu, w_ffn1_down, ln_mix, w_in,
              lambda_q1, lambda_k1, lambda_q2, lambda_k2, da_subln,
              w_branch_a, w_branch_b, w_out, ln_ffn2, w_ffn2_gu, w_ffn2_down, ln_final):
    for l in range(DEPTH):
        lambda_init = 0.8 - 0.6 * math.exp(-0.3 * l)
        x = x + 0.5 * swiglu(rms_norm(x, ln_ffn1[l]), w_ffn1_gu[l], w_ffn1_down[l])
        h = rms_norm(x, ln_mix[l])
        da_q, da_k, da_v, sb_q, sb_k, sb_v, gate_a, gate_b = jnp.split(h @ w_in[l], IN_SPLITS, axis=-1)
        o_a = diff_attention(da_q, da_k, da_v, rel_bias, lambda_q1[l], lambda_k1[l],
                             lambda_q2[l], lambda_k2[l], da_subln[l], lambda_init)
        o_b = stick_breaking_attention(sb_q, sb_k, sb_v)
        merged = (jax.nn.sigmoid(gate_a) * (o_a @ w_branch_a[l])
                  + jax.nn.sigmoid(gate_b) * (o_b @ w_branch_b[l]))
        x = x + merged @ w_out[l]
        x = x + 0.5 * swiglu(rms_norm(x, ln_ffn2[l]), w_ffn2_gu[l], w_ffn2_down[l])
    return rms_norm(x, ln_final)
```

```cpp
#include <hip/hip_runtime.h>
#include <stdint.h>
#include <math.h>

typedef unsigned short bf16_t;
typedef short bf16x8 __attribute__((ext_vector_type(8)));
typedef float f32x4 __attribute__((ext_vector_type(4)));

constexpr int D_MODEL = 2048, BATCH = 4, SEQ = 2048, M_TOK = BATCH * SEQ;
constexpr int D_FF = 5632, IN_TOTAL = 10240;
constexpr int DA_HEADS = 8, SB_HEADS = 16;
constexpr float NORM_EPS = 1e-6f, SUBLN_EPS = 1e-5f, LAMBDA_INIT = 0.2f;

__device__ __forceinline__ bf16_t f2bf(float f) { unsigned u = __float_as_uint(f); u = (u + 0x7fffu + ((u >> 16) & 1u)) >> 16; return (bf16_t)u; }
__device__ __forceinline__ float bf2f(bf16_t b) { return __uint_as_float(((unsigned)b) << 16); }
__device__ __forceinline__ float wave_sum(float v) {
#pragma unroll
    for (int o = 1; o < 64; o <<= 1) v += __shfl_xor(v, o);
    return v;
}
__device__ __forceinline__ float wave_max(float v) {
#pragma unroll
    for (int o = 1; o < 64; o <<= 1) v = fmaxf(v, __shfl_xor(v, o));
    return v;
}

template <bool OUT_BF16>
__global__ __launch_bounds__(256) void k_rmsnorm(const float* x, const float* g, void* out, float eps) {
    __shared__ float red[4];
    const int m = blockIdx.x, tid = threadIdx.x;
    const float* xr = x + (size_t)m * D_MODEL;
    float v[8]; float s = 0.f;
#pragma unroll
    for (int i = 0; i < 8; ++i) { v[i] = xr[tid + 256 * i]; s += v[i] * v[i]; }
    s = wave_sum(s);
    if ((tid & 63) == 0) red[tid >> 6] = s;
    __syncthreads();
    const float tot = red[0] + red[1] + red[2] + red[3];
    const float rstd = rsqrtf(tot * (1.0f / D_MODEL) + eps);
#pragma unroll
    for (int i = 0; i < 8; ++i) {
        const int c = tid + 256 * i; const float y = v[i] * rstd * g[c];
        if (OUT_BF16) ((bf16_t*)out)[(size_t)m * D_MODEL + c] = f2bf(y); else ((float*)out)[(size_t)m * D_MODEL + c] = y;
    }
}

enum { EPI_SWIGLU = 0, EPI_RESID = 1, EPI_STORE = 2, EPI_GATE_F32 = 3, EPI_GATE_ADD_BF16 = 4 };
struct Epi {
    bf16_t* obf; int ldo;
    const float* xin; float* xout; float alpha;
    const bf16_t* gate; int ldg;
    float* tmp;
};
template <int MODE>
__global__ __launch_bounds__(256) void k_gemm(const bf16_t* __restrict__ A, const float* __restrict__ B, int K, int ldb, int F, Epi p) {
    __shared__ __attribute__((aligned(16))) bf16_t As[128][40];
    __shared__ __attribute__((aligned(16))) bf16_t Bs[128][40];
    const int tid = threadIdx.x, wave = tid >> 6, lane = tid & 63, wr = wave >> 1, wc = wave & 1;
    const int bm = blockIdx.y * 128, bx = blockIdx.x;
    f32x4 acc[4][4];
#pragma unroll
    for (int i = 0; i < 4; ++i)
#pragma unroll
        for (int j = 0; j < 4; ++j) acc[i][j] = (f32x4){0.f, 0.f, 0.f, 0.f};
    for (int k0 = 0; k0 < K; k0 += 32) {
        {   const int r = tid >> 1, kh = (tid & 1) * 16;
            const uint4* src = (const uint4*)(A + (size_t)(bm + r) * K + k0 + kh);
            const uint4 v0 = src[0], v1 = src[1];
            *(uint4*)&As[r][kh] = v0; *(uint4*)&As[r][kh + 8] = v1; }
        {   const int kk = tid >> 3, n0 = (tid & 7) * 16;
#pragma unroll
            for (int i4 = 0; i4 < 4; ++i4) {
                const int n = n0 + i4 * 4; int gcol;
                if (MODE == EPI_SWIGLU) { const int nt = n >> 4; gcol = bx * 64 + (nt >> 1) * 16 + (n & 15) + ((nt & 1) ? F : 0); }
                else gcol = bx * 128 + n;
                const float4 v = *(const float4*)(B + (size_t)(k0 + kk) * ldb + gcol);
                Bs[n + 0][kk] = f2bf(v.x); Bs[n + 1][kk] = f2bf(v.y); Bs[n + 2][kk] = f2bf(v.z); Bs[n + 3][kk] = f2bf(v.w);
            } }
        __syncthreads();
        bf16x8 af[4], bfr[4];
#pragma unroll
        for (int mt = 0; mt < 4; ++mt) af[mt] = *(const bf16x8*)&As[wr * 64 + mt * 16 + (lane & 15)][8 * (lane >> 4)];
#pragma unroll
        for (int nt = 0; nt < 4; ++nt) bfr[nt] = *(const bf16x8*)&Bs[wc * 64 + nt * 16 + (lane & 15)][8 * (lane >> 4)];
#pragma unroll
        for (int mt = 0; mt < 4; ++mt)
#pragma unroll
            for (int nt = 0; nt < 4; ++nt) acc[mt][nt] = __builtin_amdgcn_mfma_f32_16x16x32_bf16(af[mt], bfr[nt], acc[mt][nt], 0, 0, 0);
        __syncthreads();
    }
#pragma unroll
    for (int mt = 0; mt < 4; ++mt)
#pragma unroll
        for (int r = 0; r < 4; ++r) {
            const int row = bm + wr * 64 + mt * 16 + (lane >> 4) * 4 + r;
            if (MODE == EPI_SWIGLU) {
#pragma unroll
                for (int np = 0; np < 2; ++np) {
                    const float gv = acc[mt][2 * np][r], uv = acc[mt][2 * np + 1][r];
                    const int j = bx * 64 + (wc * 2 + np) * 16 + (lane & 15);
                    const float h = gv / (1.0f + __expf(-gv)) * uv;
                    p.obf[(size_t)row * p.ldo + j] = f2bf(h);
                }
            } else {
#pragma unroll
                for (int nt = 0; nt < 4; ++nt) {
                    const int col = bx * 128 + wc * 64 + nt * 16 + (lane & 15); const float a = acc[mt][nt][r];
                    if (MODE == EPI_RESID) { const size_t o = (size_t)row * D_MODEL + col; p.xout[o] = p.xin[o] + p.alpha * a; }
                    else if (MODE == EPI_STORE) p.obf[(size_t)row * p.ldo + col] = f2bf(a);
                    else {
                        const float gt = bf2f(p.gate[(size_t)row * p.ldg + col]); const float sg = 1.0f / (1.0f + __expf(-gt));
                        const size_t o = (size_t)row * D_MODEL + col;
                        if (MODE == EPI_GATE_F32) p.tmp[o] = sg * a; else p.obf[o] = f2bf(p.tmp[o] + sg * a);
                    }
                }
            }
        }
}

__device__ __forceinline__ int rel_bucket(int rel) {
    const int ret = rel > 0 ? 16 : 0; const int n = rel < 0 ? -rel : rel;
    int b;
    if (n < 8) b = n; else if (n < 12) b = 8; else if (n < 16) b = 9; else if (n < 23) b = 10; else if (n < 32) b = 11; else if (n < 46) b = 12; else if (n < 64) b = 13; else if (n < 91) b = 14; else b = 15;
    return ret + b;
}
__global__ __launch_bounds__(128) void k_da_naive(const bf16_t* __restrict__ qkvg, const float* __restrict__ rel_bias, const float* lq1, const float* lk1, const float* lq2, const float* lk2,
                                                  const float* subln, bf16_t* OA) {
    __shared__ float sS[2][2][SEQ];
    __shared__ float sQ[2][128];
    const int tid = threadIdx.x, w = tid >> 6, lane = tid & 63;
    const int gq = blockIdx.x * 2 + w; const int q = gq % SEQ, bh = gq / SEQ, h = bh % DA_HEADS, b = bh / DA_HEADS;
    const size_t m = (size_t)b * SEQ + q;
    sQ[w][lane] = bf2f(qkvg[m * IN_TOTAL + h * 128 + lane]); sQ[w][lane + 64] = bf2f(qkvg[m * IN_TOTAL + h * 128 + 64 + lane]);
    const float lam = __expf(wave_sum(lq1[lane] * lk1[lane])) - __expf(wave_sum(lq2[lane] * lk2[lane])) + LAMBDA_INIT;
    __syncthreads();
    const int nk = (q / 64 + 1) * 64;
    float mx0 = -INFINITY, mx1 = -INFINITY;
    for (int k = lane; k < nk; k += 64) {
        const bf16_t* kr = qkvg + ((size_t)b * SEQ + k) * IN_TOTAL + 1024 + h * 128;
        float s0 = 0.f, s1 = 0.f;
#pragma unroll
        for (int c = 0; c < 8; ++c) {
            const uint4 v0 = *(const uint4*)(kr + c * 8), v1 = *(const uint4*)(kr + 64 + c * 8);
            const unsigned a0[4] = {v0.x, v0.y, v0.z, v0.w}, a1[4] = {v1.x, v1.y, v1.z, v1.w};
#pragma unroll
            for (int e = 0; e < 4; ++e) {
                s0 += sQ[w][c * 8 + 2 * e] * __uint_as_float(a0[e] << 16) + sQ[w][c * 8 + 2 * e + 1] * __uint_as_float(a0[e] & 0xffff0000u);
                s1 += sQ[w][64 + c * 8 + 2 * e] * __uint_as_float(a1[e] << 16) + sQ[w][64 + c * 8 + 2 * e + 1] * __uint_as_float(a1[e] & 0xffff0000u);
            }
        }
        const int bk = rel_bucket(k - q);
        s0 = s0 * 0.125f + rel_bias[bk * 16 + h * 2 + 0]; s1 = s1 * 0.125f + rel_bias[bk * 16 + h * 2 + 1];
        sS[w][0][k] = s0; sS[w][1][k] = s1; mx0 = fmaxf(mx0, s0); mx1 = fmaxf(mx1, s1);
    }
    mx0 = wave_max(mx0); mx1 = wave_max(mx1);
    float l0 = 0.f, l1 = 0.f;
    for (int k = lane; k < nk; k += 64) { const float p0 = __expf(sS[w][0][k] - mx0), p1 = __expf(sS[w][1][k] - mx1); sS[w][0][k] = p0; sS[w][1][k] = p1; l0 += p0; l1 += p1; }
    l0 = wave_sum(l0); l1 = wave_sum(l1);
    const float i0 = 1.0f / l0, i1 = lam / l1;
    for (int k = lane; k < nk; k += 64) sS[w][0][k] = sS[w][0][k] * i0 - sS[w][1][k] * i1;
    __syncthreads();
    float o0 = 0.f, o1 = 0.f;
    const bf16_t* vb = qkvg + (size_t)b * SEQ * IN_TOTAL + 2048 + h * 128 + 2 * lane;
    for (int k = 0; k < nk; ++k) { const float a = sS[w][0][k]; const unsigned vv = *(const unsigned*)(vb + (size_t)k * IN_TOTAL); o0 += a * __uint_as_float(vv << 16); o1 += a * __uint_as_float(vv & 0xffff0000u); }
    const float ss = wave_sum(o0 * o0 + o1 * o1);
    const float r = rsqrtf(ss * (1.0f / 128.0f) + SUBLN_EPS) * (1.0f - LAMBDA_INIT);
    OA[m * 1024 + h * 128 + 2 * lane] = f2bf(o0 * r * subln[2 * lane]); OA[m * 1024 + h * 128 + 2 * lane + 1] = f2bf(o1 * r * subln[2 * lane + 1]);
}

__global__ __launch_bounds__(256) void k_sb_naive(const bf16_t* __restrict__ qkvg, bf16_t* OB) {
    __shared__ float sW[4][SEQ];
    __shared__ float sQ[4][64];
    const int tid = threadIdx.x, w = tid >> 6, lane = tid & 63;
    const int gq = blockIdx.x * 4 + w; const int q = gq % SEQ, bh = gq / SEQ, h = bh % SB_HEADS, b = bh / SB_HEADS;
    const size_t m = (size_t)b * SEQ + q;
    sQ[w][lane] = bf2f(qkvg[m * IN_TOTAL + 3072 + h * 64 + lane]);
    __syncthreads();
    const int nchunk = (q + 63) / 64;
    float carry = 0.f;
    for (int c = nchunk - 1; c >= 0; --c) {
        const int j = c * 64 + lane; const bool valid = j < q;
        const bf16_t* kr = qkvg + ((size_t)b * SEQ + j) * IN_TOTAL + 4096 + h * 64;
        float z = 0.f;
#pragma unroll
        for (int cc = 0; cc < 8; ++cc) {
            const uint4 v0 = *(const uint4*)(kr + cc * 8); const unsigned a0[4] = {v0.x, v0.y, v0.z, v0.w};
#pragma unroll
            for (int e = 0; e < 4; ++e) z += sQ[w][cc * 8 + 2 * e] * __uint_as_float(a0[e] << 16) + sQ[w][cc * 8 + 2 * e + 1] * __uint_as_float(a0[e] & 0xffff0000u);
        }
        z *= 0.125f;
        const float sp = fmaxf(z, 0.f) + log1pf(__expf(-fabsf(z)));
        const float lk = valid ? -sp : 0.f;
        float incl = lk;
#pragma unroll
        for (int off = 1; off < 64; off <<= 1) { const float t = __shfl_down(incl, off); incl += (lane + off < 64) ? t : 0.f; }
        const float lb = carry + incl - lk;
        sW[w][j] = valid ? __expf((z - sp) + lb) : 0.f;
        carry += __shfl(incl, 0);
    }
    __syncthreads();
    float o = 0.f;
    const bf16_t* vb = qkvg + (size_t)b * SEQ * IN_TOTAL + 5120 + h * 64 + lane;
    const int nkp = nchunk * 64;
    for (int k = 0; k < nkp; ++k) o += sW[w][k] * bf2f(vb[(size_t)k * IN_TOTAL]);
    OB[m * 1024 + h * 64 + lane] = f2bf(o);
}

extern "C" void kernel_launch(void* const* d_in, const int* in_sizes, int n_in, void* d_out, int out_size, void* d_ws, size_t ws_size, hipStream_t stream) {
    const float* x = (const float*)d_in[0]; const float* rel_bias = (const float*)d_in[1];
    const float* ln_ffn1 = (const float*)d_in[2]; const float* w_gu1 = (const float*)d_in[3]; const float* w_dn1 = (const float*)d_in[4];
    const float* ln_mix = (const float*)d_in[5]; const float* w_in = (const float*)d_in[6];
    const float* lq1 = (const float*)d_in[7]; const float* lk1 = (const float*)d_in[8]; const float* lq2 = (const float*)d_in[9]; const float* lk2 = (const float*)d_in[10];
    const float* subln = (const float*)d_in[11]; const float* w_a = (const float*)d_in[12]; const float* w_b = (const float*)d_in[13]; const float* w_out = (const float*)d_in[14];
    const float* ln_ffn2 = (const float*)d_in[15]; const float* w_gu2 = (const float*)d_in[16]; const float* w_dn2 = (const float*)d_in[17]; const float* ln_final = (const float*)d_in[18];
    float* out = (float*)d_out;
    char* ws = (char*)d_ws; const size_t MiB = 1u << 20;
    bf16_t* XN = (bf16_t*)(ws); bf16_t* HB = (bf16_t*)(ws + 32 * MiB); bf16_t* QKVG = (bf16_t*)(ws + 120 * MiB);
    bf16_t* OA = (bf16_t*)(ws + 280 * MiB); bf16_t* OB = (bf16_t*)(ws + 296 * MiB); float* TMP = (float*)(ws + 312 * MiB); bf16_t* MG = (bf16_t*)(ws + 376 * MiB);
    const int M = M_TOK;
    Epi e{};
    k_rmsnorm<true><<<M, 256, 0, stream>>>(x, ln_ffn1, XN, NORM_EPS);
    e = Epi{}; e.obf = HB; e.ldo = D_FF;
    k_gemm<EPI_SWIGLU><<<dim3(D_FF / 64, M / 128), 256, 0, stream>>>(XN, w_gu1, D_MODEL, 2 * D_FF, D_FF, e);
    e = Epi{}; e.xin = x; e.xout = out; e.alpha = 0.5f;
    k_gemm<EPI_RESID><<<dim3(D_MODEL / 128, M / 128), 256, 0, stream>>>(HB, w_dn1, D_FF, D_MODEL, 0, e);
    k_rmsnorm<true><<<M, 256, 0, stream>>>(out, ln_mix, XN, NORM_EPS);
    e = Epi{}; e.obf = QKVG; e.ldo = IN_TOTAL;
    k_gemm<EPI_STORE><<<dim3(IN_TOTAL / 128, M / 128), 256, 0, stream>>>(XN, w_in, D_MODEL, IN_TOTAL, 0, e);
    k_da_naive<<<BATCH * DA_HEADS * SEQ / 2, 128, 0, stream>>>(QKVG, rel_bias, lq1, lk1, lq2, lk2, subln, OA);
    k_sb_naive<<<BATCH * SB_HEADS * SEQ / 4, 256, 0, stream>>>(QKVG, OB);
    e = Epi{}; e.gate = QKVG + 6144; e.ldg = IN_TOTAL; e.tmp = TMP;
    k_gemm<EPI_GATE_F32><<<dim3(D_MODEL / 128, M / 128), 256, 0, stream>>>(OA, w_a, 1024, D_MODEL, 0, e);
    e = Epi{}; e.gate = QKVG + 8192; e.ldg = IN_TOTAL; e.tmp = TMP; e.obf = MG;
    k_gemm<EPI_GATE_ADD_BF16><<<dim3(D_MODEL / 128, M / 128), 256, 0, stream>>>(OB, w_b, 1024, D_MODEL, 0, e);
    e = Epi{}; e.xin = out; e.xout = out; e.alpha = 1.0f;
    k_gemm<EPI_RESID><<<dim3(D_MODEL / 128, M / 128), 256, 0, stream>>>(MG, w_out, D_MODEL, D_MODEL, 0, e);
    k_rmsnorm<true><<<M, 256, 0, stream>>>(out, ln_ffn2, XN, NORM_EPS);
    e = Epi{}; e.obf = HB; e.ldo = D_FF;
    k_gemm<EPI_SWIGLU><<<dim3(D_FF / 64, M / 128), 256, 0, stream>>>(XN, w_gu2, D_MODEL, 2 * D_FF, D_FF, e);
    e = Epi{}; e.xin = out; e.xout = out; e.alpha = 0.5f;
    k_gemm<EPI_RESID><<<dim3(D_MODEL / 128, M / 128), 256, 0, stream>>>(HB, w_dn2, D_FF, D_MODEL, 0, e);
    k_rmsnorm<false><<<M, 256, 0, stream>>>(out, ln_final, out, NORM_EPS);
}
```

```cpp
#include <hip/hip_runtime.h>
#include <cstdio>
#include <cstdint>
#include <math.h>

namespace pg8 {
#define PG8_LAS __attribute__((address_space(3)))
typedef unsigned short bf16_t;
typedef short bf16x8 __attribute__((ext_vector_type(8)));
typedef float f32x4 __attribute__((ext_vector_type(4)));
typedef unsigned u32x4 __attribute__((ext_vector_type(4)));
constexpr int BM = 256, BK = 64, HALF = 128, HTB = HALF * BK * 2  , STAGE_BYTES = 8 * HTB, NXCD = 8, WGM = 8;

__host__ __device__ __forceinline__ int lds_byte(int r, int c) { const int st = (r >> 4) * 2 + (c >> 5), rr = r & 15, cc = c & 31, ob = rr * 64 + cc * 2; return st * 1024 + (ob ^ (((ob >> 9) & 1) << 5)); }
__host__ __device__ __forceinline__ void stage_rc(int b, int& R, int& C) { const int st = b / 1024, sb = b % 1024, swz = sb ^ (((sb >> 9) & 1) << 5); R = (st >> 1) * 16 + swz / 64; C = (st & 1) * 32 + (swz % 64) / 2; }
__host__ __device__ __forceinline__ int perm32(int rho) { const int n = rho >> 4, i = rho & 15; return 8 * (i >> 2) + 4 * n + (i & 3); }

struct Unit { int pm, pn; };
struct Gemm { const bf16_t* A; const bf16_t* Bt; int M, N, K; };

struct StaticOrder {
    int nM, nN, nwg, G, c;
    __host__ __device__ void init(int M, int N, int G_, int c_) { nM = M / BM; nN = N / BM; nwg = nM * nN; G = G_; c = c_; }
    __host__ __device__ bool next(int i, Unit& u) const {
        const long L = (long)i * G + c; if (L >= nwg) return false;
        int wgid = (int)L; { const int q = nwg / NXCD, r = nwg % NXCD, xcd = wgid % NXCD, off = wgid / NXCD; wgid = (xcd < r ? xcd * (q + 1) : r * (q + 1) + (xcd - r) * q) + off; }
        const int nig = WGM * nN, gid = wgid / nig, fm = gid * WGM, gsz = (nM - fm) < WGM ? (nM - fm) : WGM;
        u.pm = fm + ((wgid % nig) % gsz); u.pn = (wgid % nig) / gsz; return true;
    }
    __device__ __forceinline__ void a_ready(const Unit&) const {}
    __device__ __forceinline__ void done(const Unit&) const {}
};
__device__ __forceinline__ unsigned cvt_pk_bf16(float lo, float hi) { unsigned r; asm volatile("v_cvt_pk_bf16_f32 %0, %1, %2" : "=v"(r) : "v"(lo), "v"(hi)); return r; }
typedef float f32x2 __attribute__((ext_vector_type(2)));
constexpr float RMS_EPS = 1e-6f, LOG2E = 1.4426950408889634f;
__device__ __forceinline__ float rstd_of(float ss) { return rsqrtf(ss * (1.0f / 2048.0f) + RMS_EPS); }
__device__ __forceinline__ float sigm(float g) { return __builtin_amdgcn_rcpf(1.0f + __builtin_amdgcn_exp2f(-LOG2E * g)); }
__device__ __forceinline__ u32x4 pack8(const f32x4& a, const f32x4& b) { u32x4 w; w.x = cvt_pk_bf16(a[0], a[1]); w.y = cvt_pk_bf16(a[2], a[3]); w.z = cvt_pk_bf16(b[0], b[1]); w.w = cvt_pk_bf16(b[2], b[3]); return w; }
__device__ __forceinline__ float bflo(unsigned w) { return __uint_as_float(w << 16); }
__device__ __forceinline__ float bfhi(unsigned w) { return __uint_as_float(w & 0xffff0000u); }
template <bool SSQ> struct EpiSwiGLU {
    static constexpr bool PERM = true, AFTER_DRAIN = false;
    bf16_t* H; const float* rs;
    __device__ __forceinline__ void operator()(const f32x4 (&acc)[2][2][4][2], const Unit& u, int wr, int wc, int fr, int fq) const {
        const int row0 = u.pm * BM + wr * 64 + fr, col0 = u.pn * 128 + wc * 32 + 8 * fq;
#pragma unroll
        for (int ai = 0; ai < 2; ++ai)
#pragma unroll
            for (int m = 0; m < 4; ++m) {
                const int row = row0 + ai * HALF + m * 16;
                float r = rs[row]; if (SSQ) r = rstd_of(r);
                f32x4 h0, h1;
#pragma unroll
                for (int e = 0; e < 4; ++e) {
                    const float g0 = acc[ai][0][m][0][e] * r, g1 = acc[ai][0][m][1][e] * r;
                    h0[e] = g0 * sigm(g0) * (acc[ai][1][m][0][e] * r); h1[e] = g1 * sigm(g1) * (acc[ai][1][m][1][e] * r);
                }
                *(u32x4*)(H + (size_t)row * 5632 + col0) = pack8(h0, h1);
            }
    }
};
template <bool WRITE_BF16> struct EpiResid {
    static constexpr bool PERM = true, AFTER_DRAIN = false;
    const float* xin; float* xout; bf16_t* xb; float* ss; float alpha;
    __device__ __forceinline__ void operator()(const f32x4 (&acc)[2][2][4][2], const Unit& u, int wr, int wc, int fr, int fq) const {
        const int row0 = u.pm * BM + wr * 64 + fr, col0 = u.pn * BM + wc * 32 + 8 * fq;
#pragma unroll
        for (int ai = 0; ai < 2; ++ai)
#pragma unroll
            for (int m = 0; m < 4; ++m) {
                const int row = row0 + ai * HALF + m * 16; const size_t off = (size_t)row * 2048 + col0; float sq = 0.f;
#pragma unroll
                for (int bj = 0; bj < 2; ++bj) {
                    const f32x4 a0 = *(const f32x4*)(xin + off + bj * HALF), a1 = *(const f32x4*)(xin + off + bj * HALF + 4);
                    const f32x4 o0 = a0 + acc[ai][bj][m][0] * alpha, o1 = a1 + acc[ai][bj][m][1] * alpha;
                    *(f32x4*)(xout + off + bj * HALF) = o0; *(f32x4*)(xout + off + bj * HALF + 4) = o1;
                    sq += (o0[0] * o0[0] + o0[1] * o0[1]) + (o0[2] * o0[2] + o0[3] * o0[3]) + (o1[0] * o1[0] + o1[1] * o1[1]) + (o1[2] * o1[2] + o1[3] * o1[3]);
                    if (WRITE_BF16) *(u32x4*)(xb + off + bj * HALF) = pack8(o0, o1);
                }
                sq += __shfl_xor(sq, 16); sq += __shfl_xor(sq, 32);
                if (fq == 0) atomicAdd(ss + row, sq);
                if (m & 1) asm volatile("" ::: "memory");
            }
    }
};
struct EpiQKV {
    static constexpr bool PERM = true, AFTER_DRAIN = false;
    bf16_t* base; size_t split; const float* ss; float qscale;
    __device__ __forceinline__ void operator()(const f32x4 (&acc)[2][2][4][2], const Unit& u, int wr, int wc, int fr, int fq) const {
        const int row0 = u.pm * BM + wr * 64 + fr; int colt = u.pn * BM; const int t = colt / 1024; colt -= t * 1024;
        bf16_t* ob = base + (size_t)t * split; const float sc = (t == 0 || t == 3) ? qscale : 1.0f; const int col0 = colt + wc * 32 + 8 * fq;
#pragma unroll
        for (int ai = 0; ai < 2; ++ai)
#pragma unroll
            for (int m = 0; m < 4; ++m) {
                const int row = row0 + ai * HALF + m * 16; const float r = rstd_of(ss[row]) * sc;
#pragma unroll
                for (int bj = 0; bj < 2; ++bj) *(u32x4*)(ob + (size_t)row * 1024 + col0 + bj * HALF) = pack8(acc[ai][bj][m][0] * r, acc[ai][bj][m][1] * r);
            }
    }
};
struct EpiGate {
    static constexpr bool PERM = true, AFTER_DRAIN = false;
    bf16_t* G; const float* ss;
    __device__ __forceinline__ void operator()(const f32x4 (&acc)[2][2][4][2], const Unit& u, int wr, int wc, int fr, int fq) const {
        const int row0 = u.pm * BM + wr * 64 + fr, col0 = u.pn * BM + wc * 32 + 8 * fq;
#pragma unroll
        for (int ai = 0; ai < 2; ++ai)
#pragma unroll
            for (int m = 0; m < 4; ++m) {
                const int row = row0 + ai * HALF + m * 16; const float r = rstd_of(ss[row]);
#pragma unroll
                for (int bj = 0; bj < 2; ++bj) { f32x4 s0, s1;
#pragma unroll
                    for (int e = 0; e < 4; ++e) { s0[e] = sigm(acc[ai][bj][m][0][e] * r); s1[e] = sigm(acc[ai][bj][m][1][e] * r); }
                    *(u32x4*)(G + (size_t)row * 2048 + col0 + bj * HALF) = pack8(s0, s1); }
            }
    }
};
template <bool FIRST> struct EpiBranch {
    static constexpr bool PERM = true, AFTER_DRAIN = false;
    const bf16_t* G; float* T; bf16_t* MG;
    __device__ __forceinline__ void operator()(const f32x4 (&acc)[2][2][4][2], const Unit& u, int wr, int wc, int fr, int fq) const {
        const int row0 = u.pm * BM + wr * 64 + fr, col0 = u.pn * BM + wc * 32 + 8 * fq;
#pragma unroll
        for (int ai = 0; ai < 2; ++ai)
#pragma unroll
            for (int m = 0; m < 4; ++m) {
                const int row = row0 + ai * HALF + m * 16;
#pragma unroll
                for (int bj = 0; bj < 2; ++bj) { const size_t off = (size_t)row * 2048 + col0 + bj * HALF;
                    const u32x4 g = *(const u32x4*)(G + off);
                    f32x4 o0, o1;
                    o0[0] = bflo(g.x) * acc[ai][bj][m][0][0]; o0[1] = bfhi(g.x) * acc[ai][bj][m][0][1]; o0[2] = bflo(g.y) * acc[ai][bj][m][0][2]; o0[3] = bfhi(g.y) * acc[ai][bj][m][0][3];
                    o1[0] = bflo(g.z) * acc[ai][bj][m][1][0]; o1[1] = bfhi(g.z) * acc[ai][bj][m][1][1]; o1[2] = bflo(g.w) * acc[ai][bj][m][1][2]; o1[3] = bfhi(g.w) * acc[ai][bj][m][1][3];
                    if (FIRST) { *(f32x4*)(T + off) = o0; *(f32x4*)(T + off + 4) = o1; }
                    else { o0 += *(const f32x4*)(T + off); o1 += *(const f32x4*)(T + off + 4); *(u32x4*)(MG + off) = pack8(o0, o1); } }
                if (m & 1) asm volatile("" ::: "memory");
            }
    }
};


template <class Epi, class Sched, bool ALIGN_EPI = false, bool SP2 = false>
__device__ __forceinline__ void gemm_phase(PG8_LAS unsigned char* lds, const Gemm g, const Sched& S, const Epi& E) {
    const int tid = threadIdx.x, wid = __builtin_amdgcn_readfirstlane(tid >> 6), lane = tid & 63, wr = wid >> 2, wc = wid & 3, fr = lane & 15, fq = lane >> 4;
    const int K = g.K, nt = K / BK;
    unsigned voffA[2], voffB[2];
#pragma unroll
    for (int i = 0; i < 2; ++i) { int R, C; stage_rc(tid * 16 + i * 8192, R, C); const int Rb = Epi::PERM ? ((R & ~31) + perm32(R & 31)) : R;
        voffA[i] = (unsigned)(R * K + C) * 2u; voffB[i] = (unsigned)(Rb * K + C) * 2u; }
    const size_t kstep = (size_t)(BK * 2);
    const size_t hstep = (size_t)HALF * K * 2;
    const size_t tstep = 2 * hstep;
    const unsigned ldsw = (unsigned)wid * 1024u;
    const int aoff = lds_byte(wr * 64 + fr, fq * 8), boff = lds_byte(wc * 32 + fr, fq * 8);
#define PG8_SA(b, h) (((b) * 2 + (h)) * HTB)
#define PG8_SB(b, h) ((4 + (b) * 2 + (h)) * HTB)
#define PG8_STAGE(bufoff, gbase, voff) do { _Pragma("unroll") for (int _i = 0; _i < 2; ++_i) \
        __builtin_amdgcn_global_load_lds((const unsigned*)((const char*)(gbase) + (voff)[_i]), (PG8_LAS unsigned*)(lds + (bufoff) + ldsw + _i * 8192), 16, 0, 0); } while (0)
#define PG8_LDA(dst, b, h) do { _Pragma("unroll") for (int m = 0; m < 4; ++m) _Pragma("unroll") for (int k = 0; k < 2; ++k) dst[m][k] = *(const PG8_LAS bf16x8*)(lds + PG8_SA(b, h) + aoff + m * 2048 + k * 1024); } while (0)
#define PG8_LDB(dst, b, h) do { _Pragma("unroll") for (int n = 0; n < 2; ++n) _Pragma("unroll") for (int k = 0; k < 2; ++k) dst[n][k] = *(const PG8_LAS bf16x8*)(lds + PG8_SB(b, h) + boff + n * 2048 + k * 1024); } while (0)
#define PG8_MMA(ai, bj, At, Bt) do { __builtin_amdgcn_s_setprio(1); _Pragma("unroll") for (int m = 0; m < 4; ++m) _Pragma("unroll") for (int n = 0; n < 2; ++n) _Pragma("unroll") for (int k = 0; k < 2; ++k) \
        acc[ai][bj][m][n] = __builtin_amdgcn_mfma_f32_16x16x32_bf16(Bt[n][k], At[m][k], acc[ai][bj][m][n], 0, 0, 0); __builtin_amdgcn_s_setprio(0); } while (0)
#define PG8_WAIT_V(n) asm volatile("s_waitcnt vmcnt(" #n ")" ::: "memory")
#define PG8_WAIT_L(n) asm volatile("s_waitcnt lgkmcnt(" #n ")" ::: "memory")
#define PG8_BAR __builtin_amdgcn_s_barrier()
#define PG8_SCHED __builtin_amdgcn_sched_barrier(0)
    Unit cur, nxt; int ui = 0;
    if (!S.next(0, cur)) return;
    f32x4 acc[2][2][4][2];
#pragma unroll
    for (int a = 0; a < 2; ++a)
#pragma unroll
        for (int b = 0; b < 2; ++b)
#pragma unroll
            for (int m = 0; m < 4; ++m)
#pragma unroll
                for (int n = 0; n < 2; ++n) acc[a][b][m][n] = (f32x4){0.f, 0.f, 0.f, 0.f};
    bf16x8 At[4][2], B0[2][2], B1[2][2];
    const char* cA = (const char*)g.A + (size_t)cur.pm * tstep; const char* cB = (const char*)g.Bt + (size_t)cur.pn * tstep;
    S.a_ready(cur);
    if constexpr (SP2) {
        PG8_STAGE(PG8_SB(0, 0), cB, voffB); PG8_STAGE(PG8_SB(0, 1), cB + hstep, voffB); PG8_STAGE(PG8_SA(0, 0), cA, voffA); PG8_STAGE(PG8_SA(0, 1), cA + hstep, voffA);
        if (wr == 1) PG8_BAR;
        PG8_WAIT_V(2); PG8_BAR;
        PG8_STAGE(PG8_SB(1, 0), cB + kstep, voffB); PG8_STAGE(PG8_SA(1, 0), cA + kstep, voffA); PG8_STAGE(PG8_SB(1, 1), cB + hstep + kstep, voffB);
        PG8_WAIT_V(6); PG8_BAR;
    } else {
        PG8_STAGE(PG8_SB(0, 0), cB, voffB); PG8_STAGE(PG8_SA(0, 0), cA, voffA); PG8_STAGE(PG8_SB(0, 1), cB + hstep, voffB); PG8_STAGE(PG8_SA(0, 1), cA + hstep, voffA);
        if (wr == 1) PG8_BAR;
        PG8_WAIT_V(4); PG8_BAR;
        PG8_STAGE(PG8_SB(1, 0), cB + kstep, voffB); PG8_STAGE(PG8_SA(1, 0), cA + kstep, voffA); PG8_STAGE(PG8_SB(1, 1), cB + hstep + kstep, voffB);
        PG8_WAIT_V(6); PG8_BAR;
    }
    for (;;) {
        const bool has_next = S.next(ui + 1, nxt);
        const char* nA = has_next ? (const char*)g.A + (size_t)nxt.pm * tstep : cA; const char* nB = has_next ? (const char*)g.Bt + (size_t)nxt.pn * tstep : cB;
        for (int t = 0; t < nt; t += 2) {
            const bool last = (t == nt - 2);
            const char* a1 = cA + (size_t)(t + 1) * kstep;
            const char* a2 = last ? nA : cA + (size_t)(t + 2) * kstep; const char* b2 = last ? nB : cB + (size_t)(t + 2) * kstep;
            const char* a3 = a2 + kstep; const char* b3 = b2 + kstep;
            if (last && has_next) S.a_ready(nxt);
            if constexpr (SP2) {
            PG8_LDB(B0, 0, 0); PG8_LDB(B1, 0, 1); PG8_SCHED; PG8_LDA(At, 0, 0); PG8_STAGE(PG8_SA(1, 1), a1 + hstep, voffA);
            PG8_WAIT_V(8); PG8_WAIT_L(0); PG8_BAR; PG8_MMA(0, 0, At, B0); PG8_MMA(0, 1, At, B1); PG8_BAR; PG8_SCHED;
            PG8_LDA(At, 0, 1); PG8_STAGE(PG8_SB(0, 0), b2, voffB); PG8_STAGE(PG8_SB(0, 1), b2 + hstep, voffB); PG8_STAGE(PG8_SA(0, 0), a2, voffA);
            PG8_WAIT_V(8); PG8_WAIT_L(0); PG8_BAR; PG8_MMA(1, 0, At, B0); PG8_MMA(1, 1, At, B1); PG8_BAR; PG8_SCHED;
            PG8_LDB(B0, 1, 0); PG8_LDB(B1, 1, 1); PG8_SCHED; PG8_LDA(At, 1, 0); PG8_STAGE(PG8_SA(0, 1), a2 + hstep, voffA);
            PG8_WAIT_V(8); PG8_WAIT_L(0); PG8_BAR; PG8_MMA(0, 0, At, B0); PG8_MMA(0, 1, At, B1); PG8_BAR; PG8_SCHED;
            PG8_LDA(At, 1, 1); PG8_STAGE(PG8_SB(1, 0), b3, voffB); PG8_STAGE(PG8_SB(1, 1), b3 + hstep, voffB); PG8_STAGE(PG8_SA(1, 0), a3, voffA);
            PG8_WAIT_V(8); PG8_WAIT_L(0); PG8_BAR; PG8_MMA(1, 0, At, B0); PG8_MMA(1, 1, At, B1); PG8_BAR; PG8_SCHED;
            } else {
            PG8_LDB(B0, 0, 0); PG8_SCHED; PG8_LDA(At, 0, 0); PG8_STAGE(PG8_SA(1, 1), a1 + hstep, voffA);
            PG8_WAIT_L(8); PG8_BAR; PG8_WAIT_L(0); PG8_MMA(0, 0, At, B0); PG8_BAR; PG8_SCHED;
            PG8_LDB(B1, 0, 1); PG8_STAGE(PG8_SB(0, 0), b2, voffB);
            PG8_BAR; PG8_WAIT_L(0); PG8_MMA(0, 1, At, B1); PG8_BAR;
            PG8_LDA(At, 0, 1); PG8_STAGE(PG8_SA(0, 0), a2, voffA);
            PG8_BAR; PG8_WAIT_L(0); PG8_MMA(1, 0, At, B0); PG8_BAR; PG8_SCHED;
            PG8_STAGE(PG8_SB(0, 1), b2 + hstep, voffB);
            PG8_WAIT_V(6); PG8_BAR; PG8_MMA(1, 1, At, B1); PG8_BAR;
            PG8_LDB(B0, 1, 0); PG8_SCHED; PG8_LDA(At, 1, 0); PG8_STAGE(PG8_SA(0, 1), a2 + hstep, voffA);
            PG8_WAIT_L(8); PG8_BAR; PG8_WAIT_L(0); PG8_MMA(0, 0, At, B0); PG8_BAR; PG8_SCHED;
            PG8_LDB(B1, 1, 1); PG8_STAGE(PG8_SB(1, 0), b3, voffB);
            PG8_BAR; PG8_WAIT_L(0); PG8_MMA(0, 1, At, B1); PG8_BAR;
            PG8_LDA(At, 1, 1); PG8_STAGE(PG8_SA(1, 0), a3, voffA);
            PG8_BAR; PG8_WAIT_L(0); PG8_MMA(1, 0, At, B0); PG8_BAR; PG8_SCHED;
            PG8_STAGE(PG8_SB(1, 1), b3 + hstep, voffB);
            PG8_WAIT_V(6); PG8_BAR; PG8_MMA(1, 1, At, B1); PG8_BAR;
            }
        }
        if constexpr (ALIGN_EPI) { if (wr == 0) PG8_BAR; }
        if constexpr (!Epi::AFTER_DRAIN) { E(acc, cur, wr, wc, fr, fq); S.done(cur); }
        if (!has_next) break;
#pragma unroll
        for (int a = 0; a < 2; ++a)
#pragma unroll
            for (int b = 0; b < 2; ++b)
#pragma unroll
                for (int m = 0; m < 4; ++m)
#pragma unroll
                    for (int n = 0; n < 2; ++n) acc[a][b][m][n] = (f32x4){0.f, 0.f, 0.f, 0.f};
        cur = nxt; cA = nA; cB = nB; ++ui;
        if constexpr (ALIGN_EPI) { if (wr == 1) PG8_BAR; }
    }
    PG8_WAIT_V(0);
    if constexpr (!ALIGN_EPI) { if (wr == 0) PG8_BAR; }
    PG8_BAR;
    if constexpr (Epi::AFTER_DRAIN) { E.fused(acc, cur, wr, wc, fr, fq, lds, wid, lane); S.done(cur); }
#undef PG8_SA
#undef PG8_SB
#undef PG8_STAGE
#undef PG8_LDA
#undef PG8_LDB
#undef PG8_MMA
#undef PG8_WAIT_V
#undef PG8_WAIT_L
#undef PG8_BAR
#undef PG8_SCHED
}
}
#ifndef PG8_SP2
#define PG8_SP2 true
#endif
#ifndef PG8_ALIGN
#define PG8_ALIGN true
#endif
constexpr int NWAVES = 8;
#ifndef MK_MODE
#define MK_MODE 2
#endif
constexpr int BATCH = 4, SEQ = 2048, D = 2048, M = BATCH * SEQ, FF = 5632, NIN = 10240;
constexpr int DA_HEADS = 8, SB_HEADS = 16;
constexpr float SUBLN_EPS = 1e-5f, LAMBDA_INIT = 0.2f;
constexpr float C2 = 0.125f * 1.4426950408889634f;
constexpr size_t MiB = 1u << 20;
constexpr size_t WS_CTL = 0, CTL_ZERO_BYTES = 1 * MiB;
constexpr size_t WS_WGU1 = 2 * MiB, WS_WD1 = 46 * MiB, WS_WIN = 68 * MiB, WS_WA = 108 * MiB, WS_WB = 112 * MiB, WS_WOUT = 116 * MiB, WS_WGU2 = 124 * MiB, WS_WD2 = 168 * MiB;
constexpr size_t WS_XB = 190 * MiB;
constexpr size_t WS_H = 222 * MiB;
constexpr size_t WS_OA = 222 * MiB, WS_OB = 238 * MiB, WS_MG = 254 * MiB;
constexpr size_t WS_QKV = 310 * MiB, QKV_SPLIT = 16 * MiB;
constexpr size_t WS_G = 310 * MiB, WS_T = 342 * MiB;
constexpr size_t WS_END = 406 * MiB;
constexpr int CW_BAR = 4096;
constexpr int CW_SS2 = 32768, CW_SS3 = CW_SS2 + M, CW_SS4 = CW_SS3 + M, CW_RS1 = CW_SS4 + M;
static_assert((CW_RS1 + M) * 4 <= (int)CTL_ZERO_BYTES, "CTL words inside the memset region");
constexpr int RING_OFF = 0, RING_BYTES = 131072;
constexpr int LDSCTL_OFF = RING_BYTES, MISC_OFF = LDSCTL_OFF + 320;
constexpr int LDS_BYTES = 147456;

#define GAS __attribute__((address_space(1)))
#define LAS __attribute__((address_space(3)))
typedef unsigned short bf16;
typedef unsigned v4u __attribute__((ext_vector_type(4)));
typedef float f32x4 __attribute__((ext_vector_type(4)));
typedef short bf16x8 __attribute__((ext_vector_type(8)));
typedef GAS unsigned gu32;
typedef GAS unsigned long long gu64;
#define RLX_AGENT __ATOMIC_RELAXED, __HIP_MEMORY_SCOPE_AGENT
#define LDS_WAIT() asm volatile("s_waitcnt lgkmcnt(0)" ::: "memory")
#define VM_WAIT() asm volatile("s_waitcnt vmcnt(0)" ::: "memory")
__device__ __forceinline__ unsigned long long rt() { return __builtin_amdgcn_s_memrealtime(); }
__device__ __forceinline__ unsigned f2bf(float f) { unsigned u = __builtin_bit_cast(unsigned, f); return (u + 0x7fffu + ((u >> 16) & 1u)) >> 16; }
__device__ __forceinline__ unsigned pk2(float lo, float hi) { return f2bf(lo) | (f2bf(hi) << 16); }
#define XB_TMO      128
#define XB_XCNT(j)  (256  + 64 * (j))
#define XB_XSUB(j)  (1280 + 64 * (j))
#define XB_XGEN(j)  (2304 + 64 * (j))
#define XB_TOP      3328
#define XB_TOPGEN   3392
#define XCD_BAR_WORDS 3456
#define XB_SPIN_CAP (1u << 18)

__device__ __forceinline__ unsigned xb_ld(unsigned* p)              { return __hip_atomic_load(p, __ATOMIC_RELAXED, __HIP_MEMORY_SCOPE_AGENT); }
__device__ __forceinline__ unsigned xb_add(unsigned* p, unsigned v) { return __hip_atomic_fetch_add(p, v, __ATOMIC_RELAXED, __HIP_MEMORY_SCOPE_AGENT); }
__device__ __forceinline__ unsigned xb_xcc_id() { return (unsigned)__builtin_amdgcn_s_getreg((3 << 11) | 20) & 0xFu; }
#define XB_SPIN(cond, bar) do { unsigned _sp = 0; while (cond) { __builtin_amdgcn_s_sleep(1); \
    if ((++_sp & 255u) == 0u) { if (xb_ld(&(bar)[XB_TMO])) break; if (_sp > XB_SPIN_CAP) { atomicAdd(&(bar)[XB_TMO], 1u); break; } } } } while (0)

struct XcdBarrier {
    unsigned* bar; unsigned x;
    volatile LAS unsigned* st;
};

__device__ __forceinline__ XcdBarrier xcd_barrier_post(unsigned* bar, volatile LAS unsigned* st) {
    XcdBarrier b; b.bar = bar; b.x = xb_xcc_id(); b.st = st;
    if (threadIdx.x == 0) (void)xb_add(&bar[XB_XCNT(b.x)], 1u);
    return b;
}
__device__ __forceinline__ void xcd_barrier_complete(unsigned* bar, unsigned x, unsigned& nloc, unsigned& nx) {
    const unsigned G = gridDim.x * gridDim.y * gridDim.z;
    unsigned sum, cnt, mine, sp = 0u;
    for (;;) {
        sum = 0u; cnt = 0u; mine = 0u;
#pragma unroll
        for (unsigned j = 0; j < 16; ++j) { const unsigned c = xb_ld(&bar[XB_XCNT(j)]); sum += c; cnt += (c > 0u) ? 1u : 0u; mine = (j == x) ? c : mine; }
        if (sum == G) break;
        __builtin_amdgcn_s_sleep(1);
        if ((++sp & 255u) == 0u) { if (xb_ld(&bar[XB_TMO])) break; if (sp > XB_SPIN_CAP) { atomicAdd(&bar[XB_TMO], 1u); break; } }
    }
    nloc = mine > 0u ? mine : 1u; nx = cnt > 0u ? cnt : 1u;
}

__device__ __forceinline__ void xcd_barrier(const XcdBarrier& b) {
    asm volatile("s_waitcnt vmcnt(0)" ::: "memory");
    __syncthreads();
    if (threadIdx.x == 0) {
        unsigned* bar = b.bar;
        __builtin_amdgcn_s_waitcnt(0);
        unsigned nloc = b.st[0], nx = b.st[1];
        if (nloc == 0u) { xcd_barrier_complete(bar, b.x, nloc, nx); b.st[0] = nloc; b.st[1] = nx; }
        const unsigned old = xb_add(&bar[XB_XSUB(b.x)], 1u);
        const unsigned gen = old / nloc;
        if (old + 1u == (gen + 1u) * nloc) {
            __builtin_amdgcn_fence(__ATOMIC_RELEASE, "agent");
            asm volatile("s_waitcnt vmcnt(0)" ::: "memory");
            const unsigned og = xb_add(&bar[XB_TOP], 1u);
            const unsigned tg = og / nx;
            if (og + 1u == (tg + 1u) * nx) xb_add(&bar[XB_TOPGEN], 1u);
            else XB_SPIN(xb_ld(&bar[XB_TOPGEN]) == tg, bar);
            __builtin_amdgcn_fence(__ATOMIC_ACQUIRE, "agent");
            xb_add(&bar[XB_XGEN(b.x)], 1u);
            asm volatile("s_waitcnt vmcnt(0)" ::: "memory");
        } else {
            XB_SPIN(xb_ld(&bar[XB_XGEN(b.x)]) == gen, bar);
            __builtin_amdgcn_fence(__ATOMIC_ACQUIRE, "agent");
            asm volatile("s_waitcnt vmcnt(0)" ::: "memory");
        }
    }
    __syncthreads();
}
__device__ __forceinline__ float wave_sum(float v) {
#pragma unroll
    for (int o = 1; o < 64; o <<= 1) v += __shfl_xor(v, o);
    return v;
}
__device__ __forceinline__ float wave_max(float v) {
#pragma unroll
    for (int o = 1; o < 64; o <<= 1) v = fmaxf(v, __shfl_xor(v, o));
    return v;
}
template <bool GU>
__device__ __forceinline__ void p0_transpose_item(const float* W, int K, int N, const float* gain, bf16* WT, LAS float* scr, int item, int lane) {
    const int nblk = N / 32, kb = item / nblk, nb = item % nblk, k0 = 64 * kb, n0 = 32 * nb;
#pragma unroll 8
    for (int i = 0; i < 32; ++i) { const int kk = 2 * i + (lane >> 5); float v = W[(size_t)(k0 + kk) * N + n0 + (lane & 31)]; if (gain) v *= gain[k0 + kk]; scr[kk * 33 + (lane & 31)] = v; }
    LDS_WAIT(); asm volatile("" ::: "memory");
    int r0 = n0; if (GU) { r0 = (n0 < FF) ? (256 * (n0 / 128) + n0 % 128) : (256 * ((n0 - FF) / 128) + 128 + (n0 - FF) % 128); }
    const int c = lane & 7;
#pragma unroll
    for (int j = 0; j < 4; ++j) { const int n = (lane >> 3) + 8 * j; const LAS float* s = scr + (8 * c) * 33 + n;
        v4u o; o.x = pk2(s[0 * 33], s[1 * 33]); o.y = pk2(s[2 * 33], s[3 * 33]); o.z = pk2(s[4 * 33], s[5 * 33]); o.w = pk2(s[6 * 33], s[7 * 33]);
        *(GAS v4u*)(WT + (size_t)(r0 + n) * K + k0 + 8 * c) = o; }
    LDS_WAIT(); asm volatile("" ::: "memory");
}

__device__ __forceinline__ int rel_bucket(int rel) {
    const int ret = rel > 0 ? 16 : 0; const int n = rel < 0 ? -rel : rel;
    int b;
    if (n < 8) b = n; else if (n < 12) b = 8; else if (n < 16) b = 9; else if (n < 23) b = 10; else if (n < 32) b = 11; else if (n < 46) b = 12; else if (n < 64) b = 13; else if (n < 91) b = 14; else b = 15;
    return ret + b;
}
__device__ __forceinline__ float bf2f(bf16 b) { return __uint_as_float(((unsigned)b) << 16); }
__global__ __launch_bounds__(128) void k_da_naive(const bf16* __restrict__ DQ, const bf16* __restrict__ DK, const bf16* __restrict__ DV, const float* __restrict__ rel_bias,
                                                  const float* lq1, const float* lk1, const float* lq2, const float* lk2, const float* subln, bf16* OA) {
    __shared__ float sS[2][2][SEQ];
    __shared__ float sQ[2][128];
    const int tid = threadIdx.x, w = tid >> 6, lane = tid & 63;
    const int gq = blockIdx.x * 2 + w; const int q = gq % SEQ, bh = gq / SEQ, h = bh % DA_HEADS, b = bh / DA_HEADS;
    const size_t m = (size_t)b * SEQ + q;
    sQ[w][lane] = bf2f(DQ[m * 1024 + h * 128 + lane]); sQ[w][lane + 64] = bf2f(DQ[m * 1024 + h * 128 + 64 + lane]);
    const float lam = __expf(wave_sum(lq1[lane] * lk1[lane])) - __expf(wave_sum(lq2[lane] * lk2[lane])) + LAMBDA_INIT;
    __syncthreads();
    const int nk = (q / 64 + 1) * 64;
    float mx0 = -INFINITY, mx1 = -INFINITY;
    for (int k = lane; k < nk; k += 64) {
        const bf16* kr = DK + ((size_t)b * SEQ + k) * 1024 + h * 128;
        float s0 = 0.f, s1 = 0.f;
#pragma unroll
        for (int c = 0; c < 8; ++c) {
            const uint4 v0 = *(const uint4*)(kr + c * 8), v1 = *(const uint4*)(kr + 64 + c * 8);
            const unsigned a0[4] = {v0.x, v0.y, v0.z, v0.w}, a1[4] = {v1.x, v1.y, v1.z, v1.w};
#pragma unroll
            for (int e = 0; e < 4; ++e) {
                s0 += sQ[w][c * 8 + 2 * e] * __uint_as_float(a0[e] << 16) + sQ[w][c * 8 + 2 * e + 1] * __uint_as_float(a0[e] & 0xffff0000u);
                s1 += sQ[w][64 + c * 8 + 2 * e] * __uint_as_float(a1[e] << 16) + sQ[w][64 + c * 8 + 2 * e + 1] * __uint_as_float(a1[e] & 0xffff0000u);
            }
        }
        const int bk = rel_bucket(k - q);
        s0 = s0 + 1.4426950408889634f * rel_bias[bk * 16 + h * 2 + 0]; s1 = s1 + 1.4426950408889634f * rel_bias[bk * 16 + h * 2 + 1];
        sS[w][0][k] = s0; sS[w][1][k] = s1; mx0 = fmaxf(mx0, s0); mx1 = fmaxf(mx1, s1);
    }
    mx0 = wave_max(mx0); mx1 = wave_max(mx1);
    float l0 = 0.f, l1 = 0.f;
    for (int k = lane; k < nk; k += 64) { const float p0 = exp2f(sS[w][0][k] - mx0), p1 = exp2f(sS[w][1][k] - mx1); sS[w][0][k] = p0; sS[w][1][k] = p1; l0 += p0; l1 += p1; }
    l0 = wave_sum(l0); l1 = wave_sum(l1);
    const float i0 = 1.0f / l0, i1 = lam / l1;
    for (int k = lane; k < nk; k += 64) sS[w][0][k] = sS[w][0][k] * i0 - sS[w][1][k] * i1;
    __syncthreads();
    float o0 = 0.f, o1 = 0.f;
    const bf16* vb = DV + (size_t)b * SEQ * 1024 + h * 128 + 2 * lane;
    for (int k = 0; k < nk; ++k) { const float a = sS[w][0][k]; const unsigned vv = *(const unsigned*)(vb + (size_t)k * 1024); o0 += a * __uint_as_float(vv << 16); o1 += a * __uint_as_float(vv & 0xffff0000u); }
    const float ss = wave_sum(o0 * o0 + o1 * o1);
    const float r = rsqrtf(ss * (1.0f / 128.0f) + SUBLN_EPS) * (1.0f - LAMBDA_INIT);
    *(unsigned*)(OA + m * 1024 + h * 128 + 2 * lane) = pk2(o0 * r * subln[2 * lane], o1 * r * subln[2 * lane + 1]);
}
__global__ __launch_bounds__(256) void k_sb_naive(const bf16* __restrict__ SQ, const bf16* __restrict__ SK, const bf16* __restrict__ SV, bf16* OB) {
    __shared__ float sW[4][SEQ];
    __shared__ float sQ[4][64];
    const int tid = threadIdx.x, w = tid >> 6, lane = tid & 63;
    const int gq = blockIdx.x * 4 + w; const int q = gq % SEQ, bh = gq / SEQ, h = bh % SB_HEADS, b = bh / SB_HEADS;
    const size_t m = (size_t)b * SEQ + q;
    sQ[w][lane] = bf2f(SQ[m * 1024 + h * 64 + lane]);
    __syncthreads();
    const int nchunk = (q + 63) / 64;
    float carry = 0.f;
    for (int c = nchunk - 1; c >= 0; --c) {
        const int j = c * 64 + lane; const bool valid = j < q;
        const bf16* kr = SK + ((size_t)b * SEQ + j) * 1024 + h * 64;
        float z = 0.f;
#pragma unroll
        for (int cc = 0; cc < 8; ++cc) {
            const uint4 v0 = *(const uint4*)(kr + cc * 8); const unsigned a0[4] = {v0.x, v0.y, v0.z, v0.w};
#pragma unroll
            for (int e = 0; e < 4; ++e) z += sQ[w][cc * 8 + 2 * e] * __uint_as_float(a0[e] << 16) + sQ[w][cc * 8 + 2 * e + 1] * __uint_as_float(a0[e] & 0xffff0000u);
        }
        z *= 0.6931471805599453f;
        const float sp = fmaxf(z, 0.f) + log1pf(__expf(-fabsf(z)));
        const float lk = valid ? -sp : 0.f;
        float incl = lk;
#pragma unroll
        for (int off = 1; off < 64; off <<= 1) { const float t = __shfl_down(incl, off); incl += (lane + off < 64) ? t : 0.f; }
        const float lb = carry + incl - lk;
        sW[w][j] = valid ? __expf((z - sp) + lb) : 0.f;
        carry += __shfl(incl, 0);
    }
    __syncthreads();
    float o = 0.f;
    const bf16* vb = SV + (size_t)b * SEQ * 1024 + h * 64 + lane;
    const int nkp = nchunk * 64;
    for (int k = 0; k < nkp; ++k) o += sW[w][k] * bf2f(vb[(size_t)k * 1024]);
    OB[m * 1024 + h * 64 + lane] = (bf16)f2bf(o);
}


__device__ __forceinline__ void da_row_naive(LAS float* sS  , LAS float* sQ  , int b, int h, int q, int lane, float lam, const bf16* __restrict__ DQ, const bf16* __restrict__ DK, const bf16* __restrict__ DV,
                                             const float* __restrict__ rel_bias, const float* subln, bf16* OA) {
    const size_t m = (size_t)b * SEQ + q;
    sQ[lane] = bf2f(DQ[m * 1024 + h * 128 + lane]); sQ[lane + 64] = bf2f(DQ[m * 1024 + h * 128 + 64 + lane]);
    LDS_WAIT(); asm volatile("" ::: "memory");
    const int nk = (q / 64 + 1) * 64;
    float mx0 = -INFINITY, mx1 = -INFINITY;
    for (int k = lane; k < nk; k += 64) {
        const bf16* kr = DK + ((size_t)b * SEQ + k) * 1024 + h * 128;
        float s0 = 0.f, s1 = 0.f;
#pragma unroll
        for (int c = 0; c < 8; ++c) {
            const uint4 v0 = *(const uint4*)(kr + c * 8), v1 = *(const uint4*)(kr + 64 + c * 8);
            const unsigned a0[4] = {v0.x, v0.y, v0.z, v0.w}, a1[4] = {v1.x, v1.y, v1.z, v1.w};
#pragma unroll
            for (int e = 0; e < 4; ++e) {
                s0 += sQ[c * 8 + 2 * e] * __uint_as_float(a0[e] << 16) + sQ[c * 8 + 2 * e + 1] * __uint_as_float(a0[e] & 0xffff0000u);
                s1 += sQ[64 + c * 8 + 2 * e] * __uint_as_float(a1[e] << 16) + sQ[64 + c * 8 + 2 * e + 1] * __uint_as_float(a1[e] & 0xffff0000u);
            }
        }
        const int bk = rel_bucket(k - q);
        s0 = s0 + 1.4426950408889634f * rel_bias[bk * 16 + h * 2 + 0]; s1 = s1 + 1.4426950408889634f * rel_bias[bk * 16 + h * 2 + 1];
        sS[k] = s0; sS[SEQ + k] = s1; mx0 = fmaxf(mx0, s0); mx1 = fmaxf(mx1, s1);
    }
    mx0 = wave_max(mx0); mx1 = wave_max(mx1);
    float l0 = 0.f, l1 = 0.f;
    for (int k = lane; k < nk; k += 64) { const float p0 = exp2f(sS[k] - mx0), p1 = exp2f(sS[SEQ + k] - mx1); sS[k] = p0; sS[SEQ + k] = p1; l0 += p0; l1 += p1; }
    l0 = wave_sum(l0); l1 = wave_sum(l1);
    const float i0 = 1.0f / l0, i1 = lam / l1;
    for (int k = lane; k < nk; k += 64) sS[k] = sS[k] * i0 - sS[SEQ + k] * i1;
    LDS_WAIT(); asm volatile("" ::: "memory");
    float o0 = 0.f, o1 = 0.f;
    const bf16* vb = DV + (size_t)b * SEQ * 1024 + h * 128 + 2 * lane;
    for (int k = 0; k < nk; ++k) { const float a = sS[k]; const unsigned vv = *(const unsigned*)(vb + (size_t)k * 1024); o0 += a * __uint_as_float(vv << 16); o1 += a * __uint_as_float(vv & 0xffff0000u); }
    const float ss = wave_sum(o0 * o0 + o1 * o1);
    const float r = rsqrtf(ss * (1.0f / 128.0f) + SUBLN_EPS) * (1.0f - LAMBDA_INIT);
    *(unsigned*)(OA + m * 1024 + h * 128 + 2 * lane) = pk2(o0 * r * subln[2 * lane], o1 * r * subln[2 * lane + 1]);
    LDS_WAIT(); asm volatile("" ::: "memory");
}
__device__ __forceinline__ void sb_row_naive(LAS float* sW  , LAS float* sQ  , int b, int h, int q, int lane, const bf16* __restrict__ SQ, const bf16* __restrict__ SK, const bf16* __restrict__ SV, bf16* OB) {
    const size_t m = (size_t)b * SEQ + q;
    sQ[lane] = bf2f(SQ[m * 1024 + h * 64 + lane]);
    LDS_WAIT(); asm volatile("" ::: "memory");
    const int nchunk = (q + 63) / 64;
    float carry = 0.f;
    for (int c = nchunk - 1; c >= 0; --c) {
        const int j = c * 64 + lane; const bool valid = j < q;
        const bf16* kr = SK + ((size_t)b * SEQ + j) * 1024 + h * 64;
        float z = 0.f;
#pragma unroll
        for (int cc = 0; cc < 8; ++cc) {
            const uint4 v0 = *(const uint4*)(kr + cc * 8); const unsigned a0[4] = {v0.x, v0.y, v0.z, v0.w};
#pragma unroll
            for (int e = 0; e < 4; ++e) z += sQ[cc * 8 + 2 * e] * __uint_as_float(a0[e] << 16) + sQ[cc * 8 + 2 * e + 1] * __uint_as_float(a0[e] & 0xffff0000u);
        }
        z *= 0.6931471805599453f;
        const float sp = fmaxf(z, 0.f) + log1pf(__expf(-fabsf(z)));
        const float lk = valid ? -sp : 0.f;
        float incl = lk;
#pragma unroll
        for (int off = 1; off < 64; off <<= 1) { const float t = __shfl_down(incl, off); incl += (lane + off < 64) ? t : 0.f; }
        const float lb = carry + incl - lk;
        sW[j] = valid ? __expf((z - sp) + lb) : 0.f;
        carry += __shfl(incl, 0);
    }
    LDS_WAIT(); asm volatile("" ::: "memory");
    float o = 0.f;
    const bf16* vb = SV + (size_t)b * SEQ * 1024 + h * 64 + lane;
    const int nkp = nchunk * 64;
    for (int k = 0; k < nkp; ++k) o += sW[k] * bf2f(vb[(size_t)k * 1024]);
    OB[m * 1024 + h * 64 + lane] = (bf16)f2bf(o);
    LDS_WAIT(); asm volatile("" ::: "memory");
}

struct Args { const float* in[19]; float* out; unsigned char* ws; int ph_lo, ph_hi, li, pad; };
constexpr int N_PHASES = 10;
__global__ void __launch_bounds__(NWAVES * 64, 2) mega_fwd(Args args) {
    extern __shared__ __attribute__((aligned(16))) unsigned char lds[];
    LAS unsigned char* const L = (LAS unsigned char*)lds;
    volatile LAS unsigned* const MISC = (volatile LAS unsigned*)(L + MISC_OFF);
    const int tid = threadIdx.x, lane = tid & 63, wave = __builtin_amdgcn_readfirstlane(tid >> 6);
    const int G = gridDim.x; const int bx = blockIdx.x; const int vcu = (G % 8 == 0) ? (bx % 8) * (G / 8) + bx / 8 : bx;
    unsigned char* const ws = args.ws;
    gu32* const ctl = (gu32*)(ws + WS_CTL);
    const float* const x = args.in[0];
    float* const out = args.out;
    bf16* const XB = (bf16*)(ws + WS_XB); bf16* const HB = (bf16*)(ws + WS_H);
    float* const RS1 = (float*)(ws + WS_CTL) + CW_RS1; float* const SS2 = (float*)(ws + WS_CTL) + CW_SS2; float* const SS3 = (float*)(ws + WS_CTL) + CW_SS3; float* const SS4 = (float*)(ws + WS_CTL) + CW_SS4;
    for (int u = tid; u < (LDS_BYTES - LDSCTL_OFF) / 4; u += NWAVES * 64) ((LAS unsigned*)(L + LDSCTL_OFF))[u] = 0u;
    __syncthreads();
    const int lo = args.ph_lo, hi = args.ph_hi;
    const bool use_bar = (hi - lo) > 1;
    XcdBarrier bar; bar.bar = (unsigned*)(ctl + CW_BAR) + args.li * XCD_BAR_WORDS; bar.x = 0; bar.st = nullptr;
    if (use_bar) bar = xcd_barrier_post((unsigned*)(ctl + CW_BAR) + args.li * XCD_BAR_WORDS, MISC + 8);
#define IN(k) (lo <= (k) && (k) < hi)
#define SEAM(k) do { if (IN(k) && IN((k) + 1)) xcd_barrier(bar); } while (0)
    const int gw = vcu * NWAVES + wave, NGW = G * NWAVES;

    if (IN(0)) {
        LAS float* scr = (LAS float*)(L + RING_OFF + wave * 16384);
        constexpr int I_GU = (D / 64) * (2 * FF / 32), I_DN = (FF / 64) * (D / 32), I_IN = (D / 64) * (NIN / 32), I_BR = (1024 / 64) * (D / 32), I_OUT = (D / 64) * (D / 32);
        constexpr int NITEMS = 2 * I_GU + 2 * I_DN + I_IN + 2 * I_BR + I_OUT;
        for (int it = gw; it < NITEMS; it += NGW) {
            int r = it;
            if (r < I_GU) { p0_transpose_item<true>(args.in[3], D, 2 * FF, args.in[2], (bf16*)(ws + WS_WGU1), scr, r, lane); continue; } r -= I_GU;
            if (r < I_GU) { p0_transpose_item<true>(args.in[16], D, 2 * FF, args.in[15], (bf16*)(ws + WS_WGU2), scr, r, lane); continue; } r -= I_GU;
            if (r < I_DN) { p0_transpose_item<false>(args.in[4], FF, D, nullptr, (bf16*)(ws + WS_WD1), scr, r, lane); continue; } r -= I_DN;
            if (r < I_DN) { p0_transpose_item<false>(args.in[17], FF, D, nullptr, (bf16*)(ws + WS_WD2), scr, r, lane); continue; } r -= I_DN;
            if (r < I_IN) { p0_transpose_item<false>(args.in[6], D, NIN, args.in[5], (bf16*)(ws + WS_WIN), scr, r, lane); continue; } r -= I_IN;
            if (r < I_BR) { p0_transpose_item<false>(args.in[12], 1024, D, nullptr, (bf16*)(ws + WS_WA), scr, r, lane); continue; } r -= I_BR;
            if (r < I_BR) { p0_transpose_item<false>(args.in[13], 1024, D, nullptr, (bf16*)(ws + WS_WB), scr, r, lane); continue; } r -= I_BR;
            p0_transpose_item<false>(args.in[14], D, D, nullptr, (bf16*)(ws + WS_WOUT), scr, r, lane);
        }
        for (int m = gw; m < M; m += NGW) {
            const GAS f32x4* xr = (const GAS f32x4*)(x + (size_t)m * D) + lane;
            f32x4 v[8]; float s = 0.f;
#pragma unroll
            for (int j = 0; j < 8; ++j) { v[j] = xr[64 * j]; s += (v[j].x * v[j].x + v[j].y * v[j].y) + (v[j].z * v[j].z + v[j].w * v[j].w); }
            s = wave_sum(s);
            if (lane == 0) RS1[m] = rsqrtf(s * (1.0f / D) + 1e-6f);
            GAS unsigned long long* o8 = (GAS unsigned long long*)(XB + (size_t)m * D) + lane;
#pragma unroll
            for (int j = 0; j < 8; ++j) o8[64 * j] = (unsigned long long)pk2(v[j].x, v[j].y) | ((unsigned long long)pk2(v[j].z, v[j].w) << 32);
        }
    }
    SEAM(0);
    if (IN(1)) {
        pg8::Gemm g{XB, (const bf16*)(ws + WS_WGU1), M, 2 * FF, D}; pg8::StaticOrder S; S.init(M, 2 * FF, G, bx);
        pg8::EpiSwiGLU<false> E{HB, RS1};
        pg8::gemm_phase<pg8::EpiSwiGLU<false>, pg8::StaticOrder, PG8_ALIGN, PG8_SP2>(L + RING_OFF, g, S, E);
    }
    SEAM(1);
    if (IN(2)) {
        pg8::Gemm g{HB, (const bf16*)(ws + WS_WD1), M, D, FF}; pg8::StaticOrder S; S.init(M, D, G, bx);
        pg8::EpiResid<true> E{x, out, XB, SS2, 0.5f};
        pg8::gemm_phase<pg8::EpiResid<true>, pg8::StaticOrder, PG8_ALIGN, PG8_SP2>(L + RING_OFF, g, S, E);
    }
    SEAM(2);
    if (IN(3)) {
        pg8::Gemm g{XB, (const bf16*)(ws + WS_WIN), M, 6144, D}; pg8::StaticOrder S; S.init(M, 6144, G, bx);
        pg8::EpiQKV E{(bf16*)(ws + WS_QKV), QKV_SPLIT / 2, SS2, C2};
        pg8::gemm_phase<pg8::EpiQKV, pg8::StaticOrder, PG8_ALIGN, PG8_SP2>(L + RING_OFF, g, S, E);
    }
    SEAM(3);
    if (IN(4)) {
        const bf16* q6 = (const bf16*)(ws + WS_QKV); const size_t sp = QKV_SPLIT / 2;
        LAS float* sS = (LAS float*)(L + RING_OFF) + wave * (2 * SEQ); LAS float* sQ = (LAS float*)(L + LDSCTL_OFF + 1024) + wave * 128;
        const float lam = __expf(wave_sum(args.in[7][lane] * args.in[8][lane])) - __expf(wave_sum(args.in[9][lane] * args.in[10][lane])) + LAMBDA_INIT;
        for (int i = 0; i < BATCH * DA_HEADS; ++i) { const int q = (gw + 65 * i) & (SEQ - 1);
            da_row_naive(sS, sQ, i / DA_HEADS, i % DA_HEADS, q, lane, lam, q6, q6 + sp, q6 + 2 * sp, args.in[1], args.in[11], (bf16*)(ws + WS_OA)); }
        for (int i = 0; i < BATCH * SB_HEADS; ++i) { const int q = (gw + 65 * i) & (SEQ - 1);
            sb_row_naive(sS, sQ, i / SB_HEADS, i % SB_HEADS, q, lane, q6 + 3 * sp, q6 + 4 * sp, q6 + 5 * sp, (bf16*)(ws + WS_OB)); }
        __syncthreads();
    }
    SEAM(4);
    if (IN(5)) {
        bf16* const Gt = (bf16*)(ws + WS_G); float* const T = (float*)(ws + WS_T); bf16* const MG = (bf16*)(ws + WS_MG);
        pg8::StaticOrder S; S.init(M, D, G, bx);
        { pg8::Gemm g{XB, (const bf16*)(ws + WS_WIN) + (size_t)6144 * D, M, D, D}; pg8::EpiGate E{Gt, SS2};
          pg8::gemm_phase<pg8::EpiGate, pg8::StaticOrder, PG8_ALIGN, PG8_SP2>(L + RING_OFF, g, S, E); }
        { pg8::Gemm g{(const bf16*)(ws + WS_OA), (const bf16*)(ws + WS_WA), M, D, 1024}; pg8::EpiBranch<true> E{Gt, T, MG};
          pg8::gemm_phase<pg8::EpiBranch<true>, pg8::StaticOrder, PG8_ALIGN, PG8_SP2>(L + RING_OFF, g, S, E); }
        { pg8::Gemm g{XB, (const bf16*)(ws + WS_WIN) + (size_t)8192 * D, M, D, D}; pg8::EpiGate E{Gt, SS2};
          pg8::gemm_phase<pg8::EpiGate, pg8::StaticOrder, PG8_ALIGN, PG8_SP2>(L + RING_OFF, g, S, E); }
        { pg8::Gemm g{(const bf16*)(ws + WS_OB), (const bf16*)(ws + WS_WB), M, D, 1024}; pg8::EpiBranch<false> E{Gt, T, MG};
          pg8::gemm_phase<pg8::EpiBranch<false>, pg8::StaticOrder, PG8_ALIGN, PG8_SP2>(L + RING_OFF, g, S, E); }
    }
    SEAM(5);
    if (IN(6)) {
        pg8::Gemm g{(const bf16*)(ws + WS_MG), (const bf16*)(ws + WS_WOUT), M, D, D}; pg8::StaticOrder S; S.init(M, D, G, bx);
        pg8::EpiResid<true> E{out, out, XB, SS3, 1.0f};
        pg8::gemm_phase<pg8::EpiResid<true>, pg8::StaticOrder, PG8_ALIGN, PG8_SP2>(L + RING_OFF, g, S, E);
    }
    SEAM(6);
    if (IN(7)) {
        pg8::Gemm g{XB, (const bf16*)(ws + WS_WGU2), M, 2 * FF, D}; pg8::StaticOrder S; S.init(M, 2 * FF, G, bx);
        pg8::EpiSwiGLU<true> E{HB, SS3};
        pg8::gemm_phase<pg8::EpiSwiGLU<true>, pg8::StaticOrder, PG8_ALIGN, PG8_SP2>(L + RING_OFF, g, S, E);
    }
    SEAM(7);
    if (IN(8)) {
        pg8::Gemm g{HB, (const bf16*)(ws + WS_WD2), M, D, FF}; pg8::StaticOrder S; S.init(M, D, G, bx);
        pg8::EpiResid<false> E{out, out, nullptr, SS4, 0.5f};
        pg8::gemm_phase<pg8::EpiResid<false>, pg8::StaticOrder, PG8_ALIGN, PG8_SP2>(L + RING_OFF, g, S, E);
    }
    SEAM(8);
    if (IN(9)) {
        const float* gf = args.in[18];
        for (int m = gw; m < M; m += NGW) {
            GAS f32x4* xr = (GAS f32x4*)(out + (size_t)m * D) + lane; const GAS f32x4* gr = (const GAS f32x4*)gf + lane;
            const float r = rsqrtf(SS4[m] * (1.0f / D) + 1e-6f);
#pragma unroll
            for (int j = 0; j < 8; ++j) { const f32x4 v = xr[64 * j]; xr[64 * j] = v * r * gr[64 * j]; }
        }
    }
#undef IN
#undef SEAM
}

extern "C" void kernel_launch(void* const* d_in, const int* in_sizes, int n_in, void* d_out, int out_size, void* d_ws, size_t ws_size, hipStream_t stream) {
    static int grid = 0;
    if (grid == 0) {
        if (n_in != 19 || out_size != M * D || ws_size < WS_END) { fprintf(stderr, "kernel_launch: unexpected shapes (n_in %d out %d ws %zu)\n", n_in, out_size, ws_size); grid = -1; return; }
        int dev = 0, cus = 0, per_cu = 0;
        if (hipGetDevice(&dev) != hipSuccess || hipDeviceGetAttribute(&cus, hipDeviceAttributeMultiprocessorCount, dev) != hipSuccess) { grid = -1; return; }
        if (hipFuncSetAttribute((const void*)mega_fwd, hipFuncAttributeMaxDynamicSharedMemorySize, LDS_BYTES) != hipSuccess) { fprintf(stderr, "kernel_launch: hipFuncSetAttribute failed\n"); grid = -1; return; }
        if (hipOccupancyMaxActiveBlocksPerMultiprocessor(&per_cu, (const void*)mega_fwd, NWAVES * 64, LDS_BYTES) != hipSuccess || per_cu < 1) fprintf(stderr, "kernel_launch: occupancy query says %d\n", per_cu);
        (void)hipGetLastError();
        grid = cus;
    }
    if (grid < 0) return;
    (void)hipMemsetAsync((char*)d_ws + WS_CTL, 0, CTL_ZERO_BYTES, stream);
    Args a{};
    for (int i = 0; i < 19; ++i) a.in[i] = (const float*)d_in[i];
    a.out = (float*)d_out; a.ws = (unsigned char*)d_ws;
    unsigned char* ws = (unsigned char*)d_ws;
    auto mega = [&](int lo, int hi, int li) { a.ph_lo = lo; a.ph_hi = hi; a.li = li; hipLaunchKernelGGL(mega_fwd, dim3(grid), dim3(NWAVES * 64), LDS_BYTES, stream, a); };
    auto naive_attn = [&]() {
        const bf16* q6 = (const bf16*)(ws + WS_QKV); const size_t sp = QKV_SPLIT / 2;
        k_da_naive<<<BATCH * DA_HEADS * SEQ / 2, 128, 0, stream>>>(q6, q6 + sp, q6 + 2 * sp, a.in[1], a.in[7], a.in[8], a.in[9], a.in[10], a.in[11], (bf16*)(ws + WS_OA));
        k_sb_naive<<<BATCH * SB_HEADS * SEQ / 4, 256, 0, stream>>>(q6 + 3 * sp, q6 + 4 * sp, q6 + 5 * sp, (bf16*)(ws + WS_OB));
    };
#if MK_MODE == 0
    for (int p = 0; p < N_PHASES; ++p) { if (p == 4) naive_attn(); else mega(p, p + 1, 0); }
#elif MK_MODE == 1
    mega(0, 4, 0); naive_attn(); mega(5, N_PHASES, 1);
#else
    mega(0, N_PHASES, 0);
#endif
}
```

```cpp
#include <hip/hip_runtime.h>
#include <cstdio>
#include <cstdint>
#include <math.h>

namespace pg8 {
#define PG8_LAS __attribute__((address_space(3)))
typedef unsigned short bf16_t;
typedef short bf16x8 __attribute__((ext_vector_type(8)));
typedef float f32x4 __attribute__((ext_vector_type(4)));
typedef unsigned u32x4 __attribute__((ext_vector_type(4)));
constexpr int BM = 256, BK = 64, HALF = 128, HTB = HALF * BK * 2  , STAGE_BYTES = 8 * HTB, NXCD = 8, WGM = 8;

__host__ __device__ __forceinline__ int lds_byte(int r, int c) { const int st = (r >> 4) * 2 + (c >> 5), rr = r & 15, cc = c & 31, ob = rr * 64 + cc * 2; return st * 1024 + (ob ^ (((ob >> 9) & 1) << 5)); }
__host__ __device__ __forceinline__ void stage_rc(int b, int& R, int& C) { const int st = b / 1024, sb = b % 1024, swz = sb ^ (((sb >> 9) & 1) << 5); R = (st >> 1) * 16 + swz / 64; C = (st & 1) * 32 + (swz % 64) / 2; }
__host__ __device__ __forceinline__ int perm32(int rho) { const int n = rho >> 4, i = rho & 15; return 8 * (i >> 2) + 4 * n + (i & 3); }

struct Unit { int pm, pn; };
struct Gemm { const bf16_t* A; const bf16_t* Bt; int M, N, K; };

struct StaticOrder {
    int nM, nN, nwg, G, c;
    __host__ __device__ void init(int M, int N, int G_, int c_) { nM = M / BM; nN = N / BM; nwg = nM * nN; G = G_; c = c_; }
    __host__ __device__ bool next(int i, Unit& u) const {
        const long L = (long)i * G + c; if (L >= nwg) return false;
        int wgid = (int)L; { const int q = nwg / NXCD, r = nwg % NXCD, xcd = wgid % NXCD, off = wgid / NXCD; wgid = (xcd < r ? xcd * (q + 1) : r * (q + 1) + (xcd - r) * q) + off; }
        const int nig = WGM * nN, gid = wgid / nig, fm = gid * WGM, gsz = (nM - fm) < WGM ? (nM - fm) : WGM;
        u.pm = fm + ((wgid % nig) % gsz); u.pn = (wgid % nig) / gsz; return true;
    }
    __device__ __forceinline__ void a_ready(const Unit&) const {}
    __device__ __forceinline__ void done(const Unit&) const {}
};
__device__ __forceinline__ unsigned cvt_pk_bf16(float lo, float hi) { unsigned r; asm volatile("v_cvt_pk_bf16_f32 %0, %1, %2" : "=v"(r) : "v"(lo), "v"(hi)); return r; }
typedef float f32x2 __attribute__((ext_vector_type(2)));
constexpr float RMS_EPS = 1e-6f, LOG2E = 1.4426950408889634f;
__device__ __forceinline__ float rstd_of(float ss) { return rsqrtf(ss * (1.0f / 2048.0f) + RMS_EPS); }
__device__ __forceinline__ float sigm(float g) { return __builtin_amdgcn_rcpf(1.0f + __builtin_amdgcn_exp2f(-LOG2E * g)); }
__device__ __forceinline__ u32x4 pack8(const f32x4& a, const f32x4& b) { u32x4 w; w.x = cvt_pk_bf16(a[0], a[1]); w.y = cvt_pk_bf16(a[2], a[3]); w.z = cvt_pk_bf16(b[0], b[1]); w.w = cvt_pk_bf16(b[2], b[3]); return w; }
__device__ __forceinline__ float bflo(unsigned w) { return __uint_as_float(w << 16); }
__device__ __forceinline__ float bfhi(unsigned w) { return __uint_as_float(w & 0xffff0000u); }
template <bool SSQ> struct EpiSwiGLU {
    static constexpr bool PERM = true, AFTER_DRAIN = false;
    bf16_t* H; const float* rs;
    __device__ __forceinline__ void operator()(const f32x4 (&acc)[2][2][4][2], const Unit& u, int wr, int wc, int fr, int fq) const {
        const int row0 = u.pm * BM + wr * 64 + fr, col0 = u.pn * 128 + wc * 32 + 8 * fq;
#pragma unroll
        for (int ai = 0; ai < 2; ++ai)
#pragma unroll
            for (int m = 0; m < 4; ++m) {
                const int row = row0 + ai * HALF + m * 16;
                float r = rs[row]; if (SSQ) r = rstd_of(r);
                f32x4 h0, h1;
#pragma unroll
                for (int e = 0; e < 4; ++e) {
                    const float g0 = acc[ai][0][m][0][e] * r, g1 = acc[ai][0][m][1][e] * r;
                    h0[e] = g0 * sigm(g0) * (acc[ai][1][m][0][e] * r); h1[e] = g1 * sigm(g1) * (acc[ai][1][m][1][e] * r);
                }
                *(u32x4*)(H + (size_t)row * 5632 + col0) = pack8(h0, h1);
            }
    }
};
template <bool WRITE_BF16> struct EpiResid {
    static constexpr bool PERM = true, AFTER_DRAIN = false;
    const float* xin; float* xout; bf16_t* xb; float* ss; float alpha;
    __device__ __forceinline__ void operator()(const f32x4 (&acc)[2][2][4][2], const Unit& u, int wr, int wc, int fr, int fq) const {
        const int row0 = u.pm * BM + wr * 64 + fr, col0 = u.pn * BM + wc * 32 + 8 * fq;
#pragma unroll
        for (int ai = 0; ai < 2; ++ai)
#pragma unroll
            for (int m = 0; m < 4; ++m) {
                const int row = row0 + ai * HALF + m * 16; const size_t off = (size_t)row * 2048 + col0; float sq = 0.f;
#pragma unroll
                for (int bj = 0; bj < 2; ++bj) {
                    const f32x4 a0 = *(const f32x4*)(xin + off + bj * HALF), a1 = *(const f32x4*)(xin + off + bj * HALF + 4);
                    const f32x4 o0 = a0 + acc[ai][bj][m][0] * alpha, o1 = a1 + acc[ai][bj][m][1] * alpha;
                    *(f32x4*)(xout + off + bj * HALF) = o0; *(f32x4*)(xout + off + bj * HALF + 4) = o1;
                    sq += (o0[0] * o0[0] + o0[1] * o0[1]) + (o0[2] * o0[2] + o0[3] * o0[3]) + (o1[0] * o1[0] + o1[1] * o1[1]) + (o1[2] * o1[2] + o1[3] * o1[3]);
                    if (WRITE_BF16) *(u32x4*)(xb + off + bj * HALF) = pack8(o0, o1);
                }
                sq += __shfl_xor(sq, 16); sq += __shfl_xor(sq, 32);
                if (fq == 0) atomicAdd(ss + row, sq);
                if (m & 1) asm volatile("" ::: "memory");
            }
    }
};
struct EpiQKV {
    static constexpr bool PERM = true, AFTER_DRAIN = false;
    bf16_t* base; size_t split; const float* ss; float qscale;
    __device__ __forceinline__ void operator()(const f32x4 (&acc)[2][2][4][2], const Unit& u, int wr, int wc, int fr, int fq) const {
        const int row0 = u.pm * BM + wr * 64 + fr; int colt = u.pn * BM; const int t = colt / 1024; colt -= t * 1024;
        bf16_t* ob = base + (size_t)t * split; const float sc = (t == 0 || t == 3) ? qscale : 1.0f; const int col0 = colt + wc * 32 + 8 * fq;
#pragma unroll
        for (int ai = 0; ai < 2; ++ai)
#pragma unroll
            for (int m = 0; m < 4; ++m) {
                const int row = row0 + ai * HALF + m * 16; const float r = rstd_of(ss[row]) * sc;
#pragma unroll
                for (int bj = 0; bj < 2; ++bj) *(u32x4*)(ob + (size_t)row * 1024 + col0 + bj * HALF) = pack8(acc[ai][bj][m][0] * r, acc[ai][bj][m][1] * r);
            }
    }
};
struct EpiGate {
    static constexpr bool PERM = true, AFTER_DRAIN = false;
    bf16_t* G; const float* ss;
    __device__ __forceinline__ void operator()(const f32x4 (&acc)[2][2][4][2], const Unit& u, int wr, int wc, int fr, int fq) const {
        const int row0 = u.pm * BM + wr * 64 + fr, col0 = u.pn * BM + wc * 32 + 8 * fq;
#pragma unroll
        for (int ai = 0; ai < 2; ++ai)
#pragma unroll
            for (int m = 0; m < 4; ++m) {
                const int row = row0 + ai * HALF + m * 16; const float r = rstd_of(ss[row]);
#pragma unroll
                for (int bj = 0; bj < 2; ++bj) { f32x4 s0, s1;
#pragma unroll
                    for (int e = 0; e < 4; ++e) { s0[e] = sigm(acc[ai][bj][m][0][e] * r); s1[e] = sigm(acc[ai][bj][m][1][e] * r); }
                    *(u32x4*)(G + (size_t)row * 2048 + col0 + bj * HALF) = pack8(s0, s1); }
            }
    }
};
template <bool FIRST> struct EpiBranch {
    static constexpr bool PERM = true, AFTER_DRAIN = false;
    const bf16_t* G; float* T; bf16_t* MG;
    __device__ __forceinline__ void operator()(const f32x4 (&acc)[2][2][4][2], const Unit& u, int wr, int wc, int fr, int fq) const {
        const int row0 = u.pm * BM + wr * 64 + fr, col0 = u.pn * BM + wc * 32 + 8 * fq;
#pragma unroll
        for (int ai = 0; ai < 2; ++ai)
#pragma unroll
            for (int m = 0; m < 4; ++m) {
                const int row = row0 + ai * HALF + m * 16;
#pragma unroll
                for (int bj = 0; bj < 2; ++bj) { const size_t off = (size_t)row * 2048 + col0 + bj * HALF;
                    const u32x4 g = *(const u32x4*)(G + off);
                    f32x4 o0, o1;
                    o0[0] = bflo(g.x) * acc[ai][bj][m][0][0]; o0[1] = bfhi(g.x) * acc[ai][bj][m][0][1]; o0[2] = bflo(g.y) * acc[ai][bj][m][0][2]; o0[3] = bfhi(g.y) * acc[ai][bj][m][0][3];
                    o1[0] = bflo(g.z) * acc[ai][bj][m][1][0]; o1[1] = bfhi(g.z) * acc[ai][bj][m][1][1]; o1[2] = bflo(g.w) * acc[ai][bj][m][1][2]; o1[3] = bfhi(g.w) * acc[ai][bj][m][1][3];
                    if (FIRST) { *(f32x4*)(T + off) = o0; *(f32x4*)(T + off + 4) = o1; }
                    else { o0 += *(const f32x4*)(T + off); o1 += *(const f32x4*)(T + off + 4); *(u32x4*)(MG + off) = pack8(o0, o1); } }
                if (m & 1) asm volatile("" ::: "memory");
            }
    }
};


template <class Epi, class Sched, bool ALIGN_EPI = false, bool SP2 = false>
__device__ __forceinline__ void gemm_phase(PG8_LAS unsigned char* lds, const Gemm g, const Sched& S, const Epi& E) {
    const int tid = threadIdx.x, wid = __builtin_amdgcn_readfirstlane(tid >> 6), lane = tid & 63, wr = wid >> 2, wc = wid & 3, fr = lane & 15, fq = lane >> 4;
    const int K = g.K, nt = K / BK;
    unsigned voffA[2], voffB[2];
#pragma unroll
    for (int i = 0; i < 2; ++i) { int R, C; stage_rc(tid * 16 + i * 8192, R, C); const int Rb = Epi::PERM ? ((R & ~31) + perm32(R & 31)) : R;
        voffA[i] = (unsigned)(R * K + C) * 2u; voffB[i] = (unsigned)(Rb * K + C) * 2u; }
    const size_t kstep = (size_t)(BK * 2);
    const size_t hstep = (size_t)HALF * K * 2;
    const size_t tstep = 2 * hstep;
    const unsigned ldsw = (unsigned)wid * 1024u;
    const int aoff = lds_byte(wr * 64 + fr, fq * 8), boff = lds_byte(wc * 32 + fr, fq * 8);
#define PG8_SA(b, h) (((b) * 2 + (h)) * HTB)
#define PG8_SB(b, h) ((4 + (b) * 2 + (h)) * HTB)
#define PG8_STAGE(bufoff, gbase, voff) do { _Pragma("unroll") for (int _i = 0; _i < 2; ++_i) \
        __builtin_amdgcn_global_load_lds((const unsigned*)((const char*)(gbase) + (voff)[_i]), (PG8_LAS unsigned*)(lds + (bufoff) + ldsw + _i * 8192), 16, 0, 0); } while (0)
#define PG8_LDA(dst, b, h) do { _Pragma("unroll") for (int m = 0; m < 4; ++m) _Pragma("unroll") for (int k = 0; k < 2; ++k) dst[m][k] = *(const PG8_LAS bf16x8*)(lds + PG8_SA(b, h) + aoff + m * 2048 + k * 1024); } while (0)
#define PG8_LDB(dst, b, h) do { _Pragma("unroll") for (int n = 0; n < 2; ++n) _Pragma("unroll") for (int k = 0; k < 2; ++k) dst[n][k] = *(const PG8_LAS bf16x8*)(lds + PG8_SB(b, h) + boff + n * 2048 + k * 1024); } while (0)
#define PG8_MMA(ai, bj, At, Bt) do { __builtin_amdgcn_s_setprio(1); _Pragma("unroll") for (int m = 0; m < 4; ++m) _Pragma("unroll") for (int n = 0; n < 2; ++n) _Pragma("unroll") for (int k = 0; k < 2; ++k) \
        acc[ai][bj][m][n] = __builtin_amdgcn_mfma_f32_16x16x32_bf16(Bt[n][k], At[m][k], acc[ai][bj][m][n], 0, 0, 0); __builtin_amdgcn_s_setprio(0); } while (0)
#define PG8_WAIT_V(n) asm volatile("s_waitcnt vmcnt(" #n ")" ::: "memory")
#define PG8_WAIT_L(n) asm volatile("s_waitcnt lgkmcnt(" #n ")" ::: "memory")
#define PG8_BAR __builtin_amdgcn_s_barrier()
#define PG8_SCHED __builtin_amdgcn_sched_barrier(0)
    Unit cur, nxt; int ui = 0;
    if (!S.next(0, cur)) return;
    f32x4 acc[2][2][4][2];
#pragma unroll
    for (int a = 0; a < 2; ++a)
#pragma unroll
        for (int b = 0; b < 2; ++b)
#pragma unroll
            for (int m = 0; m < 4; ++m)
#pragma unroll
                for (int n = 0; n < 2; ++n) acc[a][b][m][n] = (f32x4){0.f, 0.f, 0.f, 0.f};
    bf16x8 At[4][2], B0[2][2], B1[2][2];
    const char* cA = (const char*)g.A + (size_t)cur.pm * tstep; const char* cB = (const char*)g.Bt + (size_t)cur.pn * tstep;
    S.a_ready(cur);
    if constexpr (SP2) {
        PG8_STAGE(PG8_SB(0, 0), cB, voffB); PG8_STAGE(PG8_SB(0, 1), cB + hstep, voffB); PG8_STAGE(PG8_SA(0, 0), cA, voffA); PG8_STAGE(PG8_SA(0, 1), cA + hstep, voffA);
        if (wr == 1) PG8_BAR;
        PG8_WAIT_V(2); PG8_BAR;
        PG8_STAGE(PG8_SB(1, 0), cB + kstep, voffB); PG8_STAGE(PG8_SA(1, 0), cA + kstep, voffA); PG8_STAGE(PG8_SB(1, 1), cB + hstep + kstep, voffB);
        PG8_WAIT_V(6); PG8_BAR;
    } else {
        PG8_STAGE(PG8_SB(0, 0), cB, voffB); PG8_STAGE(PG8_SA(0, 0), cA, voffA); PG8_STAGE(PG8_SB(0, 1), cB + hstep, voffB); PG8_STAGE(PG8_SA(0, 1), cA + hstep, voffA);
        if (wr == 1) PG8_BAR;
        PG8_WAIT_V(4); PG8_BAR;
        PG8_STAGE(PG8_SB(1, 0), cB + kstep, voffB); PG8_STAGE(PG8_SA(1, 0), cA + kstep, voffA); PG8_STAGE(PG8_SB(1, 1), cB + hstep + kstep, voffB);
        PG8_WAIT_V(6); PG8_BAR;
    }
    for (;;) {
        const bool has_next = S.next(ui + 1, nxt);
        const char* nA = has_next ? (const char*)g.A + (size_t)nxt.pm * tstep : cA; const char* nB = has_next ? (const char*)g.Bt + (size_t)nxt.pn * tstep : cB;
        for (int t = 0; t < nt; t += 2) {
            const bool last = (t == nt - 2);
            const char* a1 = cA + (size_t)(t + 1) * kstep;
            const char* a2 = last ? nA : cA + (size_t)(t + 2) * kstep; const char* b2 = last ? nB : cB + (size_t)(t + 2) * kstep;
            const char* a3 = a2 + kstep; const char* b3 = b2 + kstep;
            if (last && has_next) S.a_ready(nxt);
            if constexpr (SP2) {
            PG8_LDB(B0, 0, 0); PG8_LDB(B1, 0, 1); PG8_SCHED; PG8_LDA(At, 0, 0); PG8_STAGE(PG8_SA(1, 1), a1 + hstep, voffA);
            PG8_WAIT_V(8); PG8_WAIT_L(0); PG8_BAR; PG8_MMA(0, 0, At, B0); PG8_MMA(0, 1, At, B1); PG8_BAR; PG8_SCHED;
            PG8_LDA(At, 0, 1); PG8_STAGE(PG8_SB(0, 0), b2, voffB); PG8_STAGE(PG8_SB(0, 1), b2 + hstep, voffB); PG8_STAGE(PG8_SA(0, 0), a2, voffA);
            PG8_WAIT_V(8); PG8_WAIT_L(0); PG8_BAR; PG8_MMA(1, 0, At, B0); PG8_MMA(1, 1, At, B1); PG8_BAR; PG8_SCHED;
            PG8_LDB(B0, 1, 0); PG8_LDB(B1, 1, 1); PG8_SCHED; PG8_LDA(At, 1, 0); PG8_STAGE(PG8_SA(0, 1), a2 + hstep, voffA);
            PG8_WAIT_V(8); PG8_WAIT_L(0); PG8_BAR; PG8_MMA(0, 0, At, B0); PG8_MMA(0, 1, At, B1); PG8_BAR; PG8_SCHED;
            PG8_LDA(At, 1, 1); PG8_STAGE(PG8_SB(1, 0), b3, voffB); PG8_STAGE(PG8_SB(1, 1), b3 + hstep, voffB); PG8_STAGE(PG8_SA(1, 0), a3, voffA);
            PG8_WAIT_V(8); PG8_WAIT_L(0); PG8_BAR; PG8_MMA(1, 0, At, B0); PG8_MMA(1, 1, At, B1); PG8_BAR; PG8_SCHED;
            } else {
            PG8_LDB(B0, 0, 0); PG8_SCHED; PG8_LDA(At, 0, 0); PG8_STAGE(PG8_SA(1, 1), a1 + hstep, voffA);
            PG8_WAIT_L(8); PG8_BAR; PG8_WAIT_L(0); PG8_MMA(0, 0, At, B0); PG8_BAR; PG8_SCHED;
            PG8_LDB(B1, 0, 1); PG8_STAGE(PG8_SB(0, 0), b2, voffB);
            PG8_BAR; PG8_WAIT_L(0); PG8_MMA(0, 1, At, B1); PG8_BAR;
            PG8_LDA(At, 0, 1); PG8_STAGE(PG8_SA(0, 0), a2, voffA);
            PG8_BAR; PG8_WAIT_L(0); PG8_MMA(1, 0, At, B0); PG8_BAR; PG8_SCHED;
            PG8_STAGE(PG8_SB(0, 1), b2 + hstep, voffB);
            PG8_WAIT_V(6); PG8_BAR; PG8_MMA(1, 1, At, B1); PG8_BAR;
            PG8_LDB(B0, 1, 0); PG8_SCHED; PG8_LDA(At, 1, 0); PG8_STAGE(PG8_SA(0, 1), a2 + hstep, voffA);
            PG8_WAIT_L(8); PG8_BAR; PG8_WAIT_L(0); PG8_MMA(0, 0, At, B0); PG8_BAR; PG8_SCHED;
            PG8_LDB(B1, 1, 1); PG8_STAGE(PG8_SB(1, 0), b3, voffB);
            PG8_BAR; PG8_WAIT_L(0); PG8_MMA(0, 1, At, B1); PG8_BAR;
            PG8_LDA(At, 1, 1); PG8_STAGE(PG8_SA(1, 0), a3, voffA);
            PG8_BAR; PG8_WAIT_L(0); PG8_MMA(1, 0, At, B0); PG8_BAR; PG8_SCHED;
            PG8_STAGE(PG8_SB(1, 1), b3 + hstep, voffB);
            PG8_WAIT_V(6); PG8_BAR; PG8_MMA(1, 1, At, B1); PG8_BAR;
            }
        }
        if constexpr (ALIGN_EPI) { if (wr == 0) PG8_BAR; }
        if constexpr (!Epi::AFTER_DRAIN) { E(acc, cur, wr, wc, fr, fq); S.done(cur); }
        if (!has_next) break;
#pragma unroll
        for (int a = 0; a < 2; ++a)
#pragma unroll
            for (int b = 0; b < 2; ++b)
#pragma unroll
                for (int m = 0; m < 4; ++m)
#pragma unroll
                    for (int n = 0; n < 2; ++n) acc[a][b][m][n] = (f32x4){0.f, 0.f, 0.f, 0.f};
        cur = nxt; cA = nA; cB = nB; ++ui;
        if constexpr (ALIGN_EPI) { if (wr == 1) PG8_BAR; }
    }
    PG8_WAIT_V(0);
    if constexpr (!ALIGN_EPI) { if (wr == 0) PG8_BAR; }
    PG8_BAR;
    if constexpr (Epi::AFTER_DRAIN) { E.fused(acc, cur, wr, wc, fr, fq, lds, wid, lane); S.done(cur); }
#undef PG8_SA
#undef PG8_SB
#undef PG8_STAGE
#undef PG8_LDA
#undef PG8_LDB
#undef PG8_MMA
#undef PG8_WAIT_V
#undef PG8_WAIT_L
#undef PG8_BAR
#undef PG8_SCHED
}
}
#ifndef PG8_SP2
#define PG8_SP2 true
#endif
#ifndef PG8_ALIGN
#define PG8_ALIGN true
#endif
constexpr int NWAVES = 8;
#ifndef MK_MODE
#define MK_MODE 2
#endif
constexpr int BATCH = 4, SEQ = 2048, D = 2048, M = BATCH * SEQ, FF = 5632, NIN = 10240;
constexpr int DA_HEADS = 8, SB_HEADS = 16;
constexpr float SUBLN_EPS = 1e-5f, LAMBDA_INIT = 0.2f;
constexpr float C2 = 0.125f * 1.4426950408889634f;
constexpr size_t MiB = 1u << 20;
constexpr size_t WS_CTL = 0, CTL_ZERO_BYTES = 1 * MiB;
constexpr size_t WS_WGU1 = 2 * MiB, WS_WD1 = 46 * MiB, WS_WIN = 68 * MiB, WS_WA = 108 * MiB, WS_WB = 112 * MiB, WS_WOUT = 116 * MiB, WS_WGU2 = 124 * MiB, WS_WD2 = 168 * MiB;
constexpr size_t WS_XB = 190 * MiB;
constexpr size_t WS_H = 222 * MiB;
constexpr size_t WS_OA = 222 * MiB, WS_OB = 238 * MiB, WS_MG = 254 * MiB;
constexpr size_t WS_QKV = 310 * MiB, QKV_SPLIT = 16 * MiB;
constexpr size_t WS_G = 310 * MiB, WS_T = 342 * MiB;
constexpr size_t WS_END = 406 * MiB;
constexpr int CW_BAR = 4096;
constexpr int CW_SS2 = 32768, CW_SS3 = CW_SS2 + M, CW_SS4 = CW_SS3 + M, CW_RS1 = CW_SS4 + M;
static_assert((CW_RS1 + M) * 4 <= (int)CTL_ZERO_BYTES, "CTL words inside the memset region");
constexpr int RING_OFF = 0, RING_BYTES = 131072;
constexpr int LDSCTL_OFF = RING_BYTES, MISC_OFF = LDSCTL_OFF + 320;
constexpr int LDS_BYTES = 147456;

#define GAS __attribute__((address_space(1)))
#define LAS __attribute__((address_space(3)))
typedef unsigned short bf16;
typedef unsigned v4u __attribute__((ext_vector_type(4)));
typedef float f32x4 __attribute__((ext_vector_type(4)));
typedef short bf16x8 __attribute__((ext_vector_type(8)));
typedef GAS unsigned gu32;
typedef GAS unsigned long long gu64;
#define RLX_AGENT __ATOMIC_RELAXED, __HIP_MEMORY_SCOPE_AGENT
#define LDS_WAIT() asm volatile("s_waitcnt lgkmcnt(0)" ::: "memory")
#define VM_WAIT() asm volatile("s_waitcnt vmcnt(0)" ::: "memory")
__device__ __forceinline__ unsigned long long rt() { return __builtin_amdgcn_s_memrealtime(); }
__device__ __forceinline__ unsigned f2bf(float f) { unsigned u = __builtin_bit_cast(unsigned, f); return (u + 0x7fffu + ((u >> 16) & 1u)) >> 16; }
__device__ __forceinline__ unsigned pk2(float lo, float hi) { return f2bf(lo) | (f2bf(hi) << 16); }
#define XB_TMO      128
#define XB_XCNT(j)  (256  + 64 * (j))
#define XB_XSUB(j)  (1280 + 64 * (j))
#define XB_XGEN(j)  (2304 + 64 * (j))
#define XB_TOP      3328
#define XB_TOPGEN   3392
#define XCD_BAR_WORDS 3456
#define XB_SPIN_CAP (1u << 18)

__device__ __forceinline__ unsigned xb_ld(unsigned* p)              { return __hip_atomic_load(p, __ATOMIC_RELAXED, __HIP_MEMORY_SCOPE_AGENT); }
__device__ __forceinline__ unsigned xb_add(unsigned* p, unsigned v) { return __hip_atomic_fetch_add(p, v, __ATOMIC_RELAXED, __HIP_MEMORY_SCOPE_AGENT); }
__device__ __forceinline__ unsigned xb_xcc_id() { return (unsigned)__builtin_amdgcn_s_getreg((3 << 11) | 20) & 0xFu; }
#define XB_SPIN(cond, bar) do { unsigned _sp = 0; while (cond) { __builtin_amdgcn_s_sleep(1); \
    if ((++_sp & 255u) == 0u) { if (xb_ld(&(bar)[XB_TMO])) break; if (_sp > XB_SPIN_CAP) { atomicAdd(&(bar)[XB_TMO], 1u); break; } } } } while (0)

struct XcdBarrier {
    unsigned* bar; unsigned x;
    volatile LAS unsigned* st;
};

__device__ __forceinline__ XcdBarrier xcd_barrier_post(unsigned* bar, volatile LAS unsigned* st) {
    XcdBarrier b; b.bar = bar; b.x = xb_xcc_id(); b.st = st;
    if (threadIdx.x == 0) (void)xb_add(&bar[XB_XCNT(b.x)], 1u);
    return b;
}
__device__ __forceinline__ void xcd_barrier_complete(unsigned* bar, unsigned x, unsigned& nloc, unsigned& nx) {
    const unsigned G = gridDim.x * gridDim.y * gridDim.z;
    unsigned sum, cnt, mine, sp = 0u;
    for (;;) {
        sum = 0u; cnt = 0u; mine = 0u;
#pragma unroll
        for (unsigned j = 0; j < 16; ++j) { const unsigned c = xb_ld(&bar[XB_XCNT(j)]); sum += c; cnt += (c > 0u) ? 1u : 0u; mine = (j == x) ? c : mine; }
        if (sum == G) break;
        __builtin_amdgcn_s_sleep(1);
        if ((++sp & 255u) == 0u) { if (xb_ld(&bar[XB_TMO])) break; if (sp > XB_SPIN_CAP) { atomicAdd(&bar[XB_TMO], 1u); break; } }
    }
    nloc = mine > 0u ? mine : 1u; nx = cnt > 0u ? cnt : 1u;
}

__device__ __forceinline__ void xcd_barrier(const XcdBarrier& b) {
    asm volatile("s_waitcnt vmcnt(0)" ::: "memory");
    __syncthreads();
    if (threadIdx.x == 0) {
        unsigned* bar = b.bar;
        __builtin_amdgcn_s_waitcnt(0);
        unsigned nloc = b.st[0], nx = b.st[1];
        if (nloc == 0u) { xcd_barrier_complete(bar, b.x, nloc, nx); b.st[0] = nloc; b.st[1] = nx; }
        const unsigned old = xb_add(&bar[XB_XSUB(b.x)], 1u);
        const unsigned gen = old / nloc;
        if (old + 1u == (gen + 1u) * nloc) {
            __builtin_amdgcn_fence(__ATOMIC_RELEASE, "agent");
            asm volatile("s_waitcnt vmcnt(0)" ::: "memory");
            const unsigned og = xb_add(&bar[XB_TOP], 1u);
            const unsigned tg = og / nx;
            if (og + 1u == (tg + 1u) * nx) xb_add(&bar[XB_TOPGEN], 1u);
            else XB_SPIN(xb_ld(&bar[XB_TOPGEN]) == tg, bar);
            __builtin_amdgcn_fence(__ATOMIC_ACQUIRE, "agent");
            xb_add(&bar[XB_XGEN(b.x)], 1u);
            asm volatile("s_waitcnt vmcnt(0)" ::: "memory");
        } else {
            XB_SPIN(xb_ld(&bar[XB_XGEN(b.x)]) == gen, bar);
            __builtin_amdgcn_fence(__ATOMIC_ACQUIRE, "agent");
            asm volatile("s_waitcnt vmcnt(0)" ::: "memory");
        }
    }
    __syncthreads();
}
__device__ __forceinline__ float wave_sum(float v) {
#pragma unroll
    for (int o = 1; o < 64; o <<= 1) v += __shfl_xor(v, o);
    return v;
}
__device__ __forceinline__ float wave_max(float v) {
#pragma unroll
    for (int o = 1; o < 64; o <<= 1) v = fmaxf(v, __shfl_xor(v, o));
    return v;
}
template <bool GU>
__device__ __forceinline__ void p0_transpose_item(const float* W, int K, int N, const float* gain, bf16* WT, LAS float* scr, int item, int lane) {
    const int nblk = N / 32, kb = item / nblk, nb = item % nblk, k0 = 64 * kb, n0 = 32 * nb;
#pragma unroll 8
    for (int i = 0; i < 32; ++i) { const int kk = 2 * i + (lane >> 5); float v = W[(size_t)(k0 + kk) * N + n0 + (lane & 31)]; if (gain) v *= gain[k0 + kk]; scr[kk * 33 + (lane & 31)] = v; }
    LDS_WAIT(); asm volatile("" ::: "memory");
    int r0 = n0; if (GU) { r0 = (n0 < FF) ? (256 * (n0 / 128) + n0 % 128) : (256 * ((n0 - FF) / 128) + 128 + (n0 - FF) % 128); }
    const int c = lane & 7;
#pragma unroll
    for (int j = 0; j < 4; ++j) { const int n = (lane >> 3) + 8 * j; const LAS float* s = scr + (8 * c) * 33 + n;
        v4u o; o.x = pk2(s[0 * 33], s[1 * 33]); o.y = pk2(s[2 * 33], s[3 * 33]); o.z = pk2(s[4 * 33], s[5 * 33]); o.w = pk2(s[6 * 33], s[7 * 33]);
        *(GAS v4u*)(WT + (size_t)(r0 + n) * K + k0 + 8 * c) = o; }
    LDS_WAIT(); asm volatile("" ::: "memory");
}

__device__ __forceinline__ int rel_bucket(int rel) {
    const int ret = rel > 0 ? 16 : 0; const int n = rel < 0 ? -rel : rel;
    int b;
    if (n < 8) b = n; else if (n < 12) b = 8; else if (n < 16) b = 9; else if (n < 23) b = 10; else if (n < 32) b = 11; else if (n < 46) b = 12; else if (n < 64) b = 13; else if (n < 91) b = 14; else b = 15;
    return ret + b;
}
__device__ __forceinline__ float bf2f(bf16 b) { return __uint_as_float(((unsigned)b) << 16); }
__global__ __launch_bounds__(128) void k_da_naive(const bf16* __restrict__ DQ, const bf16* __restrict__ DK, const bf16* __restrict__ DV, const float* __restrict__ rel_bias,
                                                  const float* lq1, const float* lk1, const float* lq2, const float* lk2, const float* subln, bf16* OA) {
    __shared__ float sS[2][2][SEQ];
    __shared__ float sQ[2][128];
    const int tid = threadIdx.x, w = tid >> 6, lane = tid & 63;
    const int gq = blockIdx.x * 2 + w; const int q = gq % SEQ, bh = gq / SEQ, h = bh % DA_HEADS, b = bh / DA_HEADS;
    const size_t m = (size_t)b * SEQ + q;
    sQ[w][lane] = bf2f(DQ[m * 1024 + h * 128 + lane]); sQ[w][lane + 64] = bf2f(DQ[m * 1024 + h * 128 + 64 + lane]);
    const float lam = __expf(wave_sum(lq1[lane] * lk1[lane])) - __expf(wave_sum(lq2[lane] * lk2[lane])) + LAMBDA_INIT;
    __syncthreads();
    const int nk = (q / 64 + 1) * 64;
    float mx0 = -INFINITY, mx1 = -INFINITY;
    for (int k = lane; k < nk; k += 64) {
        const bf16* kr = DK + ((size_t)b * SEQ + k) * 1024 + h * 128;
        float s0 = 0.f, s1 = 0.f;
#pragma unroll
        for (int c = 0; c < 8; ++c) {
            const uint4 v0 = *(const uint4*)(kr + c * 8), v1 = *(const uint4*)(kr + 64 + c * 8);
            const unsigned a0[4] = {v0.x, v0.y, v0.z, v0.w}, a1[4] = {v1.x, v1.y, v1.z, v1.w};
#pragma unroll
            for (int e = 0; e < 4; ++e) {
                s0 += sQ[w][c * 8 + 2 * e] * __uint_as_float(a0[e] << 16) + sQ[w][c * 8 + 2 * e + 1] * __uint_as_float(a0[e] & 0xffff0000u);
                s1 += sQ[w][64 + c * 8 + 2 * e] * __uint_as_float(a1[e] << 16) + sQ[w][64 + c * 8 + 2 * e + 1] * __uint_as_float(a1[e] & 0xffff0000u);
            }
        }
        const int bk = rel_bucket(k - q);
        s0 = s0 + 1.4426950408889634f * rel_bias[bk * 16 + h * 2 + 0]; s1 = s1 + 1.4426950408889634f * rel_bias[bk * 16 + h * 2 + 1];
        sS[w][0][k] = s0; sS[w][1][k] = s1; mx0 = fmaxf(mx0, s0); mx1 = fmaxf(mx1, s1);
    }
    mx0 = wave_max(mx0); mx1 = wave_max(mx1);
    float l0 = 0.f, l1 = 0.f;
    for (int k = lane; k < nk; k += 64) { const float p0 = exp2f(sS[w][0][k] - mx0), p1 = exp2f(sS[w][1][k] - mx1); sS[w][0][k] = p0; sS[w][1][k] = p1; l0 += p0; l1 += p1; }
    l0 = wave_sum(l0); l1 = wave_sum(l1);
    const float i0 = 1.0f / l0, i1 = lam / l1;
    for (int k = lane; k < nk; k += 64) sS[w][0][k] = sS[w][0][k] * i0 - sS[w][1][k] * i1;
    __syncthreads();
    float o0 = 0.f, o1 = 0.f;
    const bf16* vb = DV + (size_t)b * SEQ * 1024 + h * 128 + 2 * lane;
    for (int k = 0; k < nk; ++k) { const float a = sS[w][0][k]; const unsigned vv = *(const unsigned*)(vb + (size_t)k * 1024); o0 += a * __uint_as_float(vv << 16); o1 += a * __uint_as_float(vv & 0xffff0000u); }
    const float ss = wave_sum(o0 * o0 + o1 * o1);
    const float r = rsqrtf(ss * (1.0f / 128.0f) + SUBLN_EPS) * (1.0f - LAMBDA_INIT);
    *(unsigned*)(OA + m * 1024 + h * 128 + 2 * lane) = pk2(o0 * r * subln[2 * lane], o1 * r * subln[2 * lane + 1]);
}
__global__ __launch_bounds__(256) void k_sb_naive(const bf16* __restrict__ SQ, const bf16* __restrict__ SK, const bf16* __restrict__ SV, bf16* OB) {
    __shared__ float sW[4][SEQ];
    __shared__ float sQ[4][64];
    const int tid = threadIdx.x, w = tid >> 6, lane = tid & 63;
    const int gq = blockIdx.x * 4 + w; const int q = gq % SEQ, bh = gq / SEQ, h = bh % SB_HEADS, b = bh / SB_HEADS;
    const size_t m = (size_t)b * SEQ + q;
    sQ[w][lane] = bf2f(SQ[m * 1024 + h * 64 + lane]);
    __syncthreads();
    const int nchunk = (q + 63) / 64;
    float carry = 0.f;
    for (int c = nchunk - 1; c >= 0; --c) {
        const int j = c * 64 + lane; const bool valid = j < q;
        const bf16* kr = SK + ((size_t)b * SEQ + j) * 1024 + h * 64;
        float z = 0.f;
#pragma unroll
        for (int cc = 0; cc < 8; ++cc) {
            const uint4 v0 = *(const uint4*)(kr + cc * 8); const unsigned a0[4] = {v0.x, v0.y, v0.z, v0.w};
#pragma unroll
            for (int e = 0; e < 4; ++e) z += sQ[w][cc * 8 + 2 * e] * __uint_as_float(a0[e] << 16) + sQ[w][cc * 8 + 2 * e + 1] * __uint_as_float(a0[e] & 0xffff0000u);
        }
        z *= 0.6931471805599453f;
        const float sp = fmaxf(z, 0.f) + log1pf(__expf(-fabsf(z)));
        const float lk = valid ? -sp : 0.f;
        float incl = lk;
#pragma unroll
        for (int off = 1; off < 64; off <<= 1) { const float t = __shfl_down(incl, off); incl += (lane + off < 64) ? t : 0.f; }
        const float lb = carry + incl - lk;
        sW[w][j] = valid ? __expf((z - sp) + lb) : 0.f;
        carry += __shfl(incl, 0);
    }
    __syncthreads();
    float o = 0.f;
    const bf16* vb = SV + (size_t)b * SEQ * 1024 + h * 64 + lane;
    const int nkp = nchunk * 64;
    for (int k = 0; k < nkp; ++k) o += sW[w][k] * bf2f(vb[(size_t)k * 1024]);
    OB[m * 1024 + h * 64 + lane] = (bf16)f2bf(o);
}


__device__ __forceinline__ void da_row_naive(LAS float* sS  , LAS float* sQ  , int b, int h, int q, int lane, float lam, const bf16* __restrict__ DQ, const bf16* __restrict__ DK, const bf16* __restrict__ DV,
                                             const float* __restrict__ rel_bias, const float* subln, bf16* OA) {
    const size_t m = (size_t)b * SEQ + q;
    sQ[lane] = bf2f(DQ[m * 1024 + h * 128 + lane]); sQ[lane + 64] = bf2f(DQ[m * 1024 + h * 128 + 64 + lane]);
    LDS_WAIT(); asm volatile("" ::: "memory");
    const int nk = (q / 64 + 1) * 64;
    float mx0 = -INFINITY, mx1 = -INFINITY;
    for (int k = lane; k < nk; k += 64) {
        const bf16* kr = DK + ((size_t)b * SEQ + k) * 1024 + h * 128;
        float s0 = 0.f, s1 = 0.f;
#pragma unroll
        for (int c = 0; c < 8; ++c) {
            const uint4 v0 = *(const uint4*)(kr + c * 8), v1 = *(const uint4*)(kr + 64 + c * 8);
            const unsigned a0[4] = {v0.x, v0.y, v0.z, v0.w}, a1[4] = {v1.x, v1.y, v1.z, v1.w};
#pragma unroll
            for (int e = 0; e < 4; ++e) {
                s0 += sQ[c * 8 + 2 * e] * __uint_as_float(a0[e] << 16) + sQ[c * 8 + 2 * e + 1] * __uint_as_float(a0[e] & 0xffff0000u);
                s1 += sQ[64 + c * 8 + 2 * e] * __uint_as_float(a1[e] << 16) + sQ[64 + c * 8 + 2 * e + 1] * __uint_as_float(a1[e] & 0xffff0000u);
            }
        }
        const int bk = rel_bucket(k - q);
        s0 = s0 + 1.4426950408889634f * rel_bias[bk * 16 + h * 2 + 0]; s1 = s1 + 1.4426950408889634f * rel_bias[bk * 16 + h * 2 + 1];
        sS[k] = s0; sS[SEQ + k] = s1; mx0 = fmaxf(mx0, s0); mx1 = fmaxf(mx1, s1);
    }
    mx0 = wave_max(mx0); mx1 = wave_max(mx1);
    float l0 = 0.f, l1 = 0.f;
    for (int k = lane; k < nk; k += 64) { const float p0 = exp2f(sS[k] - mx0), p1 = exp2f(sS[SEQ + k] - mx1); sS[k] = p0; sS[SEQ + k] = p1; l0 += p0; l1 += p1; }
    l0 = wave_sum(l0); l1 = wave_sum(l1);
    const float i0 = 1.0f / l0, i1 = lam / l1;
    for (int k = lane; k < nk; k += 64) sS[k] = sS[k] * i0 - sS[SEQ + k] * i1;
    LDS_WAIT(); asm volatile("" ::: "memory");
    float o0 = 0.f, o1 = 0.f;
    const bf16* vb = DV + (size_t)b * SEQ * 1024 + h * 128 + 2 * lane;
    for (int k = 0; k < nk; ++k) { const float a = sS[k]; const unsigned vv = *(const unsigned*)(vb + (size_t)k * 1024); o0 += a * __uint_as_float(vv << 16); o1 += a * __uint_as_float(vv & 0xffff0000u); }
    const float ss = wave_sum(o0 * o0 + o1 * o1);
    const float r = rsqrtf(ss * (1.0f / 128.0f) + SUBLN_EPS) * (1.0f - LAMBDA_INIT);
    *(unsigned*)(OA + m * 1024 + h * 128 + 2 * lane) = pk2(o0 * r * subln[2 * lane], o1 * r * subln[2 * lane + 1]);
    LDS_WAIT(); asm volatile("" ::: "memory");
}
__device__ __forceinline__ void sb_row_naive(LAS float* sW  , LAS float* sQ  , int b, int h, int q, int lane, const bf16* __restrict__ SQ, const bf16* __restrict__ SK, const bf16* __restrict__ SV, bf16* OB) {
    const size_t m = (size_t)b * SEQ + q;
    sQ[lane] = bf2f(SQ[m * 1024 + h * 64 + lane]);
    LDS_WAIT(); asm volatile("" ::: "memory");
    const int nchunk = (q + 63) / 64;
    float carry = 0.f;
    for (int c = nchunk - 1; c >= 0; --c) {
        const int j = c * 64 + lane; const bool valid = j < q;
        const bf16* kr = SK + ((size_t)b * SEQ + j) * 1024 + h * 64;
        float z = 0.f;
#pragma unroll
        for (int cc = 0; cc < 8; ++cc) {
            const uint4 v0 = *(const uint4*)(kr + cc * 8); const unsigned a0[4] = {v0.x, v0.y, v0.z, v0.w};
#pragma unroll
            for (int e = 0; e < 4; ++e) z += sQ[cc * 8 + 2 * e] * __uint_as_float(a0[e] << 16) + sQ[cc * 8 + 2 * e + 1] * __uint_as_float(a0[e] & 0xffff0000u);
        }
        z *= 0.6931471805599453f;
        const float sp = fmaxf(z, 0.f) + log1pf(__expf(-fabsf(z)));
        const float lk = valid ? -sp : 0.f;
        float incl = lk;
#pragma unroll
        for (int off = 1; off < 64; off <<= 1) { const float t = __shfl_down(incl, off); incl += (lane + off < 64) ? t : 0.f; }
        const float lb = carry + incl - lk;
        sW[j] = valid ? __expf((z - sp) + lb) : 0.f;
        carry += __shfl(incl, 0);
    }
    LDS_WAIT(); asm volatile("" ::: "memory");
    float o = 0.f;
    const bf16* vb = SV + (size_t)b * SEQ * 1024 + h * 64 + lane;
    const int nkp = nchunk * 64;
    for (int k = 0; k < nkp; ++k) o += sW[k] * bf2f(vb[(size_t)k * 1024]);
    OB[m * 1024 + h * 64 + lane] = (bf16)f2bf(o);
    LDS_WAIT(); asm volatile("" ::: "memory");
}

namespace att {
typedef __attribute__((ext_vector_type(8))) short bf16x8;
typedef __attribute__((ext_vector_type(4))) short s16x4;
typedef __attribute__((ext_vector_type(16))) float f32x16;
typedef __attribute__((ext_vector_type(4))) unsigned u32x4;
typedef __attribute__((address_space(3))) const char* lds_cptr;
#define ATT_LAS __attribute__((address_space(3)))
#define SBAR() __builtin_amdgcn_sched_barrier(0)
#define WAIT_BAR0() asm volatile("s_waitcnt vmcnt(0) lgkmcnt(0)\n\ts_barrier" ::: "memory")
#define LDS_BAR() asm volatile("s_waitcnt lgkmcnt(0)\n\ts_barrier" ::: "memory")
__device__ __forceinline__ int crowc(int r) { return (r & 3) + 8 * (r >> 2); }
__device__ __forceinline__ void glds16(const void* gsrc, unsigned lds_dst) { unsigned keep;
    asm volatile("s_mov_b32 %0, m0\n\ts_mov_b32 m0, %2\n\ts_nop 0\n\tglobal_load_lds_dwordx4 %1, off\n\ts_mov_b32 m0, %0" : "=&s"(keep) : "v"(gsrc), "s"(lds_dst) : "memory"); }
typedef float f32x2_t __attribute__((ext_vector_type(2))); typedef __bf16 bf16x2_t __attribute__((ext_vector_type(2)));
__device__ __forceinline__ unsigned cvtpk_s(float lo, float hi) { f32x2_t v = {lo, hi}; bf16x2_t b = __builtin_convertvector(v, bf16x2_t); return __builtin_bit_cast(unsigned, b); }
__device__ __forceinline__ void qkt(f32x16& p0, f32x16& p1, lds_cptr Kslot, const bf16x8* qr, const f32x16& cinit, int r32, int hi) {
    lds_cptr kb = Kslot + hi * 1024 + r32 * 16;
#pragma unroll
    for (int d0 = 0; d0 < 4; ++d0) {
        const bf16x8 b0 = *(const ATT_LAS bf16x8*)(kb + d0 * 2048);
        const bf16x8 b1 = *(const ATT_LAS bf16x8*)(kb + d0 * 2048 + 512);
        if (d0 == 0) { p0 = __builtin_amdgcn_mfma_f32_32x32x16_bf16(b0, qr[0], cinit, 0, 0, 0); p1 = __builtin_amdgcn_mfma_f32_32x32x16_bf16(b1, qr[0], cinit, 0, 0, 0); }
        else { p0 = __builtin_amdgcn_mfma_f32_32x32x16_bf16(b0, qr[d0], p0, 0, 0, 0); p1 = __builtin_amdgcn_mfma_f32_32x32x16_bf16(b1, qr[d0], p1, 0, 0, 0); } }
}
__device__ __forceinline__ void pv(f32x16* o, int vb, bf16x8 pa0, bf16x8 pa1, bf16x8 pa2, bf16x8 pa3) {
#pragma unroll
    for (int d0 = 0; d0 < 2; ++d0) { s16x4 lo[4], hi[4];
#pragma unroll
        for (int ks = 0; ks < 4; ++ks) {
            asm volatile("ds_read_b64_tr_b16 %0,%1 offset:%c2" : "=&v"(lo[ks]) : "v"(vb), "i"(d0 * 4096 + ks * 1024) : "memory");
            asm volatile("ds_read_b64_tr_b16 %0,%1 offset:%c2" : "=&v"(hi[ks]) : "v"(vb), "i"(d0 * 4096 + ks * 1024 + 512) : "memory"); }
        asm volatile("s_waitcnt lgkmcnt(0)" ::: "memory"); SBAR();
#define PK(k) (bf16x8){lo[k][0], lo[k][1], lo[k][2], lo[k][3], hi[k][0], hi[k][1], hi[k][2], hi[k][3]}
        o[d0] = __builtin_amdgcn_mfma_f32_32x32x16_bf16(pa0, PK(0), o[d0], 0, 0, 0);
        o[d0] = __builtin_amdgcn_mfma_f32_32x32x16_bf16(pa1, PK(1), o[d0], 0, 0, 0);
        o[d0] = __builtin_amdgcn_mfma_f32_32x32x16_bf16(pa2, PK(2), o[d0], 0, 0, 0);
        o[d0] = __builtin_amdgcn_mfma_f32_32x32x16_bf16(pa3, PK(3), o[d0], 0, 0, 0);
#undef PK
    }
}
#define PKW(P, B) cvtpk_s(P[B], P[(B) + 1])
#define PACK_P(P0, P1) do { pw0 = (u32x4){PKW(P0, 0), PKW(P0, 2), PKW(P0, 4), PKW(P0, 6)}; pw1 = (u32x4){PKW(P0, 8), PKW(P0, 10), PKW(P0, 12), PKW(P0, 14)}; \
                            pw2 = (u32x4){PKW(P1, 0), PKW(P1, 2), PKW(P1, 4), PKW(P1, 6)}; pw3 = (u32x4){PKW(P1, 8), PKW(P1, 10), PKW(P1, 12), PKW(P1, 14)}; } while (0)
#define PAF(k) __builtin_bit_cast(bf16x8, pw##k)

__device__ __forceinline__ void sb_unit(int b, int h, int qb, const bf16* SQ, const bf16* __restrict__ SK, const bf16* __restrict__ SV, bf16* OB, ATT_LAS unsigned char* Lb) {
    const int tid = threadIdx.x, lane = tid & 63, r32 = lane & 31, hi = lane >> 5; const int wid = __builtin_amdgcn_readfirstlane(tid >> 6);
    const long rowbase = (long)b * SEQ; const int q0 = qb * 256;
    const bf16* Qw = SQ + (rowbase + q0 + wid * 32) * 1024 + h * 64;
    const bf16* Kh = SK + rowbase * 1024 + h * 64; const bf16* Vh = SV + rowbase * 1024 + h * 64;
    const unsigned lds0 = (unsigned)(uintptr_t)Lb;
    const bf16* ksrc = Kh + (long)lane * 1024 + wid * 8;
    const bf16* vsrc = Vh + (long)(16 * (wid & 3) + (lane >> 2)) * 1024 + (wid >> 2) * 32 + (lane & 3) * 8;
    const unsigned kdst = lds0 + wid * 1024, vdst = lds0 + 8192 + wid * 1024;
#define DMA_K(t, slot) glds16(ksrc + (long)(t) * 64 * 1024, (unsigned)__builtin_amdgcn_readfirstlane(kdst + (slot)))
#define DMA_V(t, slot) glds16(vsrc + (long)(t) * 64 * 1024, (unsigned)__builtin_amdgcn_readfirstlane(vdst + (slot)))
    const int vb0 = (int)(lds0 + 8192) + ((lane >> 4) & 1) * 32 + (lane & 3) * 8 + (4 * hi + ((lane & 15) >> 2)) * 64;
    const int NT = 4 * (qb + 1);
    DMA_K(NT - 1, 0); DMA_V(NT - 1, 0);
    bf16x8 qr[4];
#pragma unroll
    for (int d0 = 0; d0 < 4; ++d0) qr[d0] = *reinterpret_cast<const bf16x8*>(&Qw[(long)r32 * 1024 + d0 * 16 + hi * 8]);
    f32x16 o[2]; o[0] = f32x16{}; o[1] = f32x16{};
    const f32x16 zero = f32x16{};
    float R = 0.f;
    const int qrel = wid * 32 + r32;
    for (int n = 0; n < NT; ++n) {
        const int t = NT - 1 - n; const int slot = (n & 1) * 16384;
        WAIT_BAR0();
        if (n + 1 < NT) { DMA_K(t - 1, slot ^ 16384); DMA_V(t - 1, slot ^ 16384); }
        const int jb = t - 4 * qb;
        const bool skip = (jb >= 0) && (64 * jb > 32 * wid + 30);
        if (!skip) {
            const bool partial = (jb >= 0) && !(64 * jb + 63 < 32 * wid);
            f32x16 p0, p1;
            qkt(p0, p1, (lds_cptr)(Lb + slot), qr, zero, r32, hi);
            const int kb = 64 * jb + 4 * hi;
            float lk0[16], lk1[16];
#pragma unroll
            for (int r = 0; r < 16; ++r) {
                { const float y = p0[r]; const float sp = fmaxf(y, 0.f) + __builtin_amdgcn_logf(1.0f + __builtin_amdgcn_exp2f(-fabsf(y)));
                  const bool v = !partial || (kb + crowc(r) < qrel); lk0[r] = v ? -sp : 0.f; p0[r] = v ? (y - sp) : -INFINITY; }
                { const float y = p1[r]; const float sp = fmaxf(y, 0.f) + __builtin_amdgcn_logf(1.0f + __builtin_amdgcn_exp2f(-fabsf(y)));
                  const bool v = !partial || (kb + 32 + crowc(r) < qrel); lk1[r] = v ? -sp : 0.f; p1[r] = v ? (y - sp) : -INFINITY; }
            }
            float G[8], PG[8], S8[8];
#pragma unroll
            for (int gi = 0; gi < 4; ++gi) { G[gi] = (lk0[4 * gi] + lk0[4 * gi + 1]) + (lk0[4 * gi + 2] + lk0[4 * gi + 3]); G[4 + gi] = (lk1[4 * gi] + lk1[4 * gi + 1]) + (lk1[4 * gi + 2] + lk1[4 * gi + 3]); }
#pragma unroll
            for (int gi = 0; gi < 8; ++gi) PG[gi] = __shfl_xor(G[gi], 32);
            S8[7] = 0.f;
#pragma unroll
            for (int gi = 6; gi >= 0; --gi) S8[gi] = S8[gi + 1] + (G[gi + 1] + PG[gi + 1]);
            const float total = S8[0] + (G[0] + PG[0]);
#pragma unroll
            for (int gi = 0; gi < 8; ++gi) {
                const float s3 = R + S8[gi] + (hi ? 0.f : PG[gi]);
                if (gi < 4) { const float s2 = s3 + lk0[4 * gi + 3], s1 = s2 + lk0[4 * gi + 2], s0 = s1 + lk0[4 * gi + 1];
                    p0[4 * gi + 3] = __builtin_amdgcn_exp2f(p0[4 * gi + 3] + s3); p0[4 * gi + 2] = __builtin_amdgcn_exp2f(p0[4 * gi + 2] + s2);
                    p0[4 * gi + 1] = __builtin_amdgcn_exp2f(p0[4 * gi + 1] + s1); p0[4 * gi] = __builtin_amdgcn_exp2f(p0[4 * gi] + s0); }
                else { const int g4 = gi - 4; const float s2 = s3 + lk1[4 * g4 + 3], s1 = s2 + lk1[4 * g4 + 2], s0 = s1 + lk1[4 * g4 + 1];
                    p1[4 * g4 + 3] = __builtin_amdgcn_exp2f(p1[4 * g4 + 3] + s3); p1[4 * g4 + 2] = __builtin_amdgcn_exp2f(p1[4 * g4 + 2] + s2);
                    p1[4 * g4 + 1] = __builtin_amdgcn_exp2f(p1[4 * g4 + 1] + s1); p1[4 * g4] = __builtin_amdgcn_exp2f(p1[4 * g4] + s0); }
            }
            R += total;
            u32x4 pw0, pw1, pw2, pw3; PACK_P(p0, p1);
            SBAR(); pv(o, vb0 + slot, PAF(0), PAF(1), PAF(2), PAF(3));
        }
    }
    bf16* Ow = OB + (rowbase + q0 + wid * 32) * 1024 + h * 64;
    {   ATT_LAS bf16* stg = (ATT_LAS bf16*)(Lb + 65536) + wid * 2048;
#pragma unroll
        for (int r = 0; r < 16; ++r) { const int orow = crowc(r) + 4 * hi;
#pragma unroll
            for (int d0 = 0; d0 < 2; ++d0) stg[orow * 64 + d0 * 32 + r32] = (bf16)f2bf(o[d0][r]); }
        asm volatile("s_waitcnt lgkmcnt(0)" ::: "memory");
#pragma unroll
        for (int i = 0; i < 4; ++i) { const int row = i * 8 + (lane >> 3), ch = lane & 7; const u32x4 v = *(const ATT_LAS u32x4*)(stg + row * 64 + ch * 8); *(u32x4*)(Ow + (long)row * 1024 + ch * 8) = v; } }
    LDS_BAR();
#undef DMA_K
#undef DMA_V
}

__device__ __forceinline__ void da_unit(int b, int h, int iu, const bf16* DQ, const bf16* __restrict__ DK, const bf16* __restrict__ DV, bf16* OA, ATT_LAS unsigned char* Lb, ATT_LAS float* TB, ATT_LAS float* wsf_all,
                                        const float* __restrict__ rel_bias, const float* __restrict__ subln, float lam) {
    const int tid = threadIdx.x, lane = tid & 63, r32 = lane & 31, hi = lane >> 5; const int wid = __builtin_amdgcn_readfirstlane(tid >> 6);
    const int qblk = wid & 3, mp = wid >> 2;
    const long rowbase = (long)b * SEQ; const int q0 = iu * 128;
    const int c = 2 * iu + (qblk >> 1);
    const int qc = 32 * (qblk & 1) + r32;
    ATT_LAS float* wsf = wsf_all + wid * 64;
    {   const int mm = tid >> 8, i = tid & 255; const int rel = i - 191;
        TB[mm * 256 + i] = (i < 255) ? rel_bias[rel_bucket(rel) * 16 + 2 * h + mm] * 1.4426950408889634f : 0.f; }
    const float bfar = rel_bias[15 * 16 + 2 * h + mp] * 1.4426950408889634f;
    const bf16* Qw = DQ + (rowbase + q0 + 32 * qblk) * 1024 + h * 128 + mp * 64;
    const unsigned lds0 = (unsigned)(uintptr_t)Lb;
    const bf16* ksrc = DK + (rowbase + lane) * 1024 + h * 128 + wid * 8;
    const bf16* vsrc = DV + (rowbase + 16 * (wid & 3) + (lane >> 2)) * 1024 + h * 128 + (wid >> 2) * 32 + (lane & 3) * 8;
    const unsigned pdst = lds0 + wid * 1024;
#define DMA_TILE(t, slot) do { const unsigned d_ = (unsigned)__builtin_amdgcn_readfirstlane(pdst + (slot)); const long to_ = (long)(t) * 64 * 1024; \
        glds16(ksrc + to_, d_); glds16(ksrc + to_ + 64, d_ + 8192); glds16(vsrc + to_, d_ + 16384); glds16(vsrc + to_ + 64, d_ + 24576); } while (0)
    const int vb0 = (int)(lds0 + 16384) + ((lane >> 4) & 1) * 32 + (lane & 3) * 8 + (4 * hi + ((lane & 15) >> 2)) * 64;
    const int NT = 2 * iu + 2;
    DMA_TILE(0, 0);
    bf16x8 qr[4];
#pragma unroll
    for (int d0 = 0; d0 < 4; ++d0) qr[d0] = *reinterpret_cast<const bf16x8*>(&Qw[(long)r32 * 1024 + d0 * 16 + hi * 8]);
    f32x16 o[4]; o[0] = f32x16{}; o[1] = f32x16{}; o[2] = f32x16{}; o[3] = f32x16{};
    float mrun = -1e30f, lsum = 0.f;
    for (int n = 0; n < NT; ++n) {
        const int t = n; const int slot = (n & 1) * 32768;
        WAIT_BAR0();
        if (n + 1 < NT) DMA_TILE(t + 1, slot ^ 32768);
        if (t <= c) {
            const bool near = (t >= c - 2);
            const float ci = near ? 0.f : bfar;
            f32x16 cinit;
#pragma unroll
            for (int r = 0; r < 16; ++r) cinit[r] = ci;
            f32x16 p0, p1;
            qkt(p0, p1, (lds_cptr)(Lb + slot + mp * 8192), qr, cinit, r32, hi);
            if (near) {
                const ATT_LAS float* tbp = TB + mp * 256 + (64 * (t - c + 2) + 63 - qc + 4 * hi);
#pragma unroll
                for (int r = 0; r < 16; ++r) { p0[r] += tbp[crowc(r)]; p1[r] += tbp[32 + crowc(r)]; }
            }
            float rm = fmaxf(p0[0], p1[0]);
#pragma unroll
            for (int r = 1; r < 16; ++r) rm = fmaxf(rm, fmaxf(p0[r], p1[r]));
            rm = fmaxf(rm, __shfl_xor(rm, 32));
            const float mnew = fmaxf(mrun, rm); const float f = __builtin_amdgcn_exp2f(mrun - mnew); mrun = mnew;
            if (hi == 0) wsf[r32] = f;
            float ps = 0.f;
#pragma unroll
            for (int r = 0; r < 16; ++r) { p0[r] = __builtin_amdgcn_exp2f(p0[r] - mnew); p1[r] = __builtin_amdgcn_exp2f(p1[r] - mnew); ps += p0[r] + p1[r]; }
            lsum = lsum * f + ps;
            asm volatile("s_waitcnt lgkmcnt(0)" ::: "memory");
#pragma unroll
            for (int r = 0; r < 16; ++r) { const float fr_ = wsf[crowc(r) + 4 * hi];
#pragma unroll
                for (int d = 0; d < 4; ++d) o[d][r] *= fr_; }
            u32x4 pw0, pw1, pw2, pw3; PACK_P(p0, p1);
            SBAR(); pv(o, vb0 + slot, PAF(0), PAF(1), PAF(2), PAF(3));
            SBAR(); pv(o + 2, vb0 + slot + 8192, PAF(0), PAF(1), PAF(2), PAF(3));
        }
    }
    {   const float lt = lsum + __shfl_xor(lsum, 32); float inv = 1.0f / lt; if (mp == 1) inv *= lam;
        asm volatile("s_waitcnt lgkmcnt(0)" ::: "memory");
        if (hi == 0) wsf[r32] = inv;
        asm volatile("s_waitcnt lgkmcnt(0)" ::: "memory");
#pragma unroll
        for (int r = 0; r < 16; ++r) { const float fr_ = wsf[crowc(r) + 4 * hi];
#pragma unroll
            for (int d = 0; d < 4; ++d) o[d][r] *= fr_; } }
    LDS_BAR();
    ATT_LAS float* X = (ATT_LAS float*)Lb + (size_t)qblk * (4 * 16 * 64) + lane;
    if (mp == 1) {
#pragma unroll
        for (int d = 0; d < 4; ++d)
#pragma unroll
            for (int r = 0; r < 16; ++r) X[(d * 16 + r) * 64] = o[d][r];
    }
    LDS_BAR();
    if (mp == 0) {
        float ssq[16];
#pragma unroll
        for (int r = 0; r < 16; ++r) { float s = 0.f;
#pragma unroll
            for (int d = 0; d < 4; ++d) { o[d][r] -= X[(d * 16 + r) * 64]; s += o[d][r] * o[d][r]; }
            ssq[r] = s; }
#pragma unroll
        for (int r = 0; r < 16; ++r) {
#pragma unroll
            for (int off = 1; off < 32; off <<= 1) ssq[r] += __shfl_xor(ssq[r], off);
            ssq[r] = rsqrtf(ssq[r] * (1.0f / 128.0f) + SUBLN_EPS) * (1.0f - LAMBDA_INIT); }
        bf16* Ow = OA + (rowbase + q0 + 32 * qblk) * 1024 + h * 128 + r32;
#pragma unroll
        for (int d = 0; d < 4; ++d) { const float gsub = subln[32 * d + r32];
#pragma unroll
            for (int r = 0; r < 16; ++r) Ow[(long)(crowc(r) + 4 * hi) * 1024 + 32 * d] = (bf16)f2bf(o[d][r] * ssq[r] * gsub); }
    }
    LDS_BAR();
#undef DMA_TILE
}
#undef PKW
#undef PACK_P
#undef PAF
#undef SBAR
#undef WAIT_BAR0
#undef LDS_BAR
}

struct Args { const float* in[19]; float* out; unsigned char* ws; int ph_lo, ph_hi, li, pad; };
constexpr int N_PHASES = 10;
__global__ void __launch_bounds__(NWAVES * 64, 2) mega_fwd(Args args) {
    extern __shared__ __attribute__((aligned(16))) unsigned char lds[];
    LAS unsigned char* const L = (LAS unsigned char*)lds;
    volatile LAS unsigned* const MISC = (volatile LAS unsigned*)(L + MISC_OFF);
    const int tid = threadIdx.x, lane = tid & 63, wave = __builtin_amdgcn_readfirstlane(tid >> 6);
    const int G = gridDim.x; const int bx = blockIdx.x; const int vcu = (G % 8 == 0) ? (bx % 8) * (G / 8) + bx / 8 : bx;
    unsigned char* const ws = args.ws;
    gu32* const ctl = (gu32*)(ws + WS_CTL);
    const float* const x = args.in[0];
    float* const out = args.out;
    bf16* const XB = (bf16*)(ws + WS_XB); bf16* const HB = (bf16*)(ws + WS_H);
    float* const RS1 = (float*)(ws + WS_CTL) + CW_RS1; float* const SS2 = (float*)(ws + WS_CTL) + CW_SS2; float* const SS3 = (float*)(ws + WS_CTL) + CW_SS3; float* const SS4 = (float*)(ws + WS_CTL) + CW_SS4;
    for (int u = tid; u < (LDS_BYTES - LDSCTL_OFF) / 4; u += NWAVES * 64) ((LAS unsigned*)(L + LDSCTL_OFF))[u] = 0u;
    __syncthreads();
    const int lo = args.ph_lo, hi = args.ph_hi;
    const bool use_bar = (hi - lo) > 1;
    XcdBarrier bar; bar.bar = (unsigned*)(ctl + CW_BAR) + args.li * XCD_BAR_WORDS; bar.x = 0; bar.st = nullptr;
    if (use_bar) bar = xcd_barrier_post((unsigned*)(ctl + CW_BAR) + args.li * XCD_BAR_WORDS, MISC + 8);
#define IN(k) (lo <= (k) && (k) < hi)
#define SEAM(k) do { if (IN(k) && IN((k) + 1)) xcd_barrier(bar); } while (0)
    const int gw = vcu * NWAVES + wave, NGW = G * NWAVES;

    if (IN(0)) {
        LAS float* scr = (LAS float*)(L + RING_OFF + wave * 16384);
        constexpr int I_GU = (D / 64) * (2 * FF / 32), I_DN = (FF / 64) * (D / 32), I_IN = (D / 64) * (NIN / 32), I_BR = (1024 / 64) * (D / 32), I_OUT = (D / 64) * (D / 32);
        constexpr int NITEMS = 2 * I_GU + 2 * I_DN + I_IN + 2 * I_BR + I_OUT;
        for (int it = gw; it < NITEMS; it += NGW) {
            int r = it;
            if (r < I_GU) { p0_transpose_item<true>(args.in[3], D, 2 * FF, args.in[2], (bf16*)(ws + WS_WGU1), scr, r, lane); continue; } r -= I_GU;
            if (r < I_GU) { p0_transpose_item<true>(args.in[16], D, 2 * FF, args.in[15], (bf16*)(ws + WS_WGU2), scr, r, lane); continue; } r -= I_GU;
            if (r < I_DN) { p0_transpose_item<false>(args.in[4], FF, D, nullptr, (bf16*)(ws + WS_WD1), scr, r, lane); continue; } r -= I_DN;
            if (r < I_DN) { p0_transpose_item<false>(args.in[17], FF, D, nullptr, (bf16*)(ws + WS_WD2), scr, r, lane); continue; } r -= I_DN;
            if (r < I_IN) { p0_transpose_item<false>(args.in[6], D, NIN, args.in[5], (bf16*)(ws + WS_WIN), scr, r, lane); continue; } r -= I_IN;
            if (r < I_BR) { p0_transpose_item<false>(args.in[12], 1024, D, nullptr, (bf16*)(ws + WS_WA), scr, r, lane); continue; } r -= I_BR;
            if (r < I_BR) { p0_transpose_item<false>(args.in[13], 1024, D, nullptr, (bf16*)(ws + WS_WB), scr, r, lane); continue; } r -= I_BR;
            p0_transpose_item<false>(args.in[14], D, D, nullptr, (bf16*)(ws + WS_WOUT), scr, r, lane);
        }
        for (int m = gw; m < M; m += NGW) {
            const GAS f32x4* xr = (const GAS f32x4*)(x + (size_t)m * D) + lane;
            f32x4 v[8]; float s = 0.f;
#pragma unroll
            for (int j = 0; j < 8; ++j) { v[j] = xr[64 * j]; s += (v[j].x * v[j].x + v[j].y * v[j].y) + (v[j].z * v[j].z + v[j].w * v[j].w); }
            s = wave_sum(s);
            if (lane == 0) RS1[m] = rsqrtf(s * (1.0f / D) + 1e-6f);
            GAS unsigned long long* o8 = (GAS unsigned long long*)(XB + (size_t)m * D) + lane;
#pragma unroll
            for (int j = 0; j < 8; ++j) o8[64 * j] = (unsigned long long)pk2(v[j].x, v[j].y) | ((unsigned long long)pk2(v[j].z, v[j].w) << 32);
        }
    }
    SEAM(0);
    if (IN(1)) {
        pg8::Gemm g{XB, (const bf16*)(ws + WS_WGU1), M, 2 * FF, D}; pg8::StaticOrder S; S.init(M, 2 * FF, G, bx);
        pg8::EpiSwiGLU<false> E{HB, RS1};
        pg8::gemm_phase<pg8::EpiSwiGLU<false>, pg8::StaticOrder, PG8_ALIGN, PG8_SP2>(L + RING_OFF, g, S, E);
    }
    SEAM(1);
    if (IN(2)) {
        pg8::Gemm g{HB, (const bf16*)(ws + WS_WD1), M, D, FF}; pg8::StaticOrder S; S.init(M, D, G, bx);
        pg8::EpiResid<true> E{x, out, XB, SS2, 0.5f};
        pg8::gemm_phase<pg8::EpiResid<true>, pg8::StaticOrder, PG8_ALIGN, PG8_SP2>(L + RING_OFF, g, S, E);
    }
    SEAM(2);
    if (IN(3)) {
        pg8::Gemm g{XB, (const bf16*)(ws + WS_WIN), M, 6144, D}; pg8::StaticOrder S; S.init(M, 6144, G, bx);
        pg8::EpiQKV E{(bf16*)(ws + WS_QKV), QKV_SPLIT / 2, SS2, C2};
        pg8::gemm_phase<pg8::EpiQKV, pg8::StaticOrder, PG8_ALIGN, PG8_SP2>(L + RING_OFF, g, S, E);
    }
    SEAM(3);
    if (IN(4)) {
        const bf16* q6 = (const bf16*)(ws + WS_QKV); const size_t sp = QKV_SPLIT / 2;
#ifndef ATT_NAIVE_DA
        {   const float lam = __expf(wave_sum(args.in[7][lane] * args.in[8][lane])) - __expf(wave_sum(args.in[9][lane] * args.in[10][lane])) + LAMBDA_INIT;
            LAS float* TB = (LAS float*)(L + LDSCTL_OFF + 1024); LAS float* wsf = (LAS float*)(L + LDSCTL_OFF + 4096);
            const int bh = vcu >> 3, s8 = vcu & 7;
            for (int i = 0; i < 2; ++i)
                att::da_unit(bh / DA_HEADS, bh % DA_HEADS, i == 0 ? 15 - s8 : s8, q6, q6 + sp, q6 + 2 * sp, (bf16*)(ws + WS_OA), L + RING_OFF, TB, wsf, args.in[1], args.in[11], lam);
        }
#endif
#ifndef ATT_NAIVE_SB
        {   const int bh = vcu >> 2, s4 = vcu & 3;
            for (int i = 0; i < 2; ++i)
                att::sb_unit(bh / SB_HEADS, bh % SB_HEADS, i == 0 ? 7 - s4 : s4, q6 + 3 * sp, q6 + 4 * sp, q6 + 5 * sp, (bf16*)(ws + WS_OB), L + RING_OFF);
        }
#endif
#if defined(ATT_NAIVE_DA) || defined(ATT_NAIVE_SB)
        {   LAS float* sS = (LAS float*)(L + RING_OFF) + wave * (2 * SEQ); LAS float* sQ = (LAS float*)(L + LDSCTL_OFF + 1024) + wave * 128;
            __syncthreads();
#ifdef ATT_NAIVE_DA
            const float lam = __expf(wave_sum(args.in[7][lane] * args.in[8][lane])) - __expf(wave_sum(args.in[9][lane] * args.in[10][lane])) + LAMBDA_INIT;
            for (int i = 0; i < BATCH * DA_HEADS; ++i) { const int q = (gw + 65 * i) & (SEQ - 1);
                da_row_naive(sS, sQ, i / DA_HEADS, i % DA_HEADS, q, lane, lam, q6, q6 + sp, q6 + 2 * sp, args.in[1], args.in[11], (bf16*)(ws + WS_OA)); }
#endif
#ifdef ATT_NAIVE_SB
            for (int i = 0; i < BATCH * SB_HEADS; ++i) { const int q = (gw + 65 * i) & (SEQ - 1);
                sb_row_naive(sS, sQ, i / SB_HEADS, i % SB_HEADS, q, lane, q6 + 3 * sp, q6 + 4 * sp, q6 + 5 * sp, (bf16*)(ws + WS_OB)); }
#endif
            __syncthreads();
        }
#endif
    }
    SEAM(4);
    if (IN(5)) {
        bf16* const Gt = (bf16*)(ws + WS_G); float* const T = (float*)(ws + WS_T); bf16* const MG = (bf16*)(ws + WS_MG);
        pg8::StaticOrder S; S.init(M, D, G, bx);
        { pg8::Gemm g{XB, (const bf16*)(ws + WS_WIN) + (size_t)6144 * D, M, D, D}; pg8::EpiGate E{Gt, SS2};
          pg8::gemm_phase<pg8::EpiGate, pg8::StaticOrder, PG8_ALIGN, PG8_SP2>(L + RING_OFF, g, S, E); }
        { pg8::Gemm g{(const bf16*)(ws + WS_OA), (const bf16*)(ws + WS_WA), M, D, 1024}; pg8::EpiBranch<true> E{Gt, T, MG};
          pg8::gemm_phase<pg8::EpiBranch<true>, pg8::StaticOrder, PG8_ALIGN, PG8_SP2>(L + RING_OFF, g, S, E); }
        { pg8::Gemm g{XB, (const bf16*)(ws + WS_WIN) + (size_t)8192 * D, M, D, D}; pg8::EpiGate E{Gt, SS2};
          pg8::gemm_phase<pg8::EpiGate, pg8::StaticOrder, PG8_ALIGN, PG8_SP2>(L + RING_OFF, g, S, E); }
        { pg8::Gemm g{(const bf16*)(ws + WS_OB), (const bf16*)(ws + WS_WB), M, D, 1024}; pg8::EpiBranch<false> E{Gt, T, MG};
          pg8::gemm_phase<pg8::EpiBranch<false>, pg8::StaticOrder, PG8_ALIGN, PG8_SP2>(L + RING_OFF, g, S, E); }
    }
    SEAM(5);
    if (IN(6)) {
        pg8::Gemm g{(const bf16*)(ws + WS_MG), (const bf16*)(ws + WS_WOUT), M, D, D}; pg8::StaticOrder S; S.init(M, D, G, bx);
        pg8::EpiResid<true> E{out, out, XB, SS3, 1.0f};
        pg8::gemm_phase<pg8::EpiResid<true>, pg8::StaticOrder, PG8_ALIGN, PG8_SP2>(L + RING_OFF, g, S, E);
    }
    SEAM(6);
    if (IN(7)) {
        pg8::Gemm g{XB, (const bf16*)(ws + WS_WGU2), M, 2 * FF, D}; pg8::StaticOrder S; S.init(M, 2 * FF, G, bx);
        pg8::EpiSwiGLU<true> E{HB, SS3};
        pg8::gemm_phase<pg8::EpiSwiGLU<true>, pg8::StaticOrder, PG8_ALIGN, PG8_SP2>(L + RING_OFF, g, S, E);
    }
    SEAM(7);
    if (IN(8)) {
        pg8::Gemm g{HB, (const bf16*)(ws + WS_WD2), M, D, FF}; pg8::StaticOrder S; S.init(M, D, G, bx);
        pg8::EpiResid<false> E{out, out, nullptr, SS4, 0.5f};
        pg8::gemm_phase<pg8::EpiResid<false>, pg8::StaticOrder, PG8_ALIGN, PG8_SP2>(L + RING_OFF, g, S, E);
    }
    SEAM(8);
    if (IN(9)) {
        const float* gf = args.in[18];
        for (int m = gw; m < M; m += NGW) {
            GAS f32x4* xr = (GAS f32x4*)(out + (size_t)m * D) + lane; const GAS f32x4* gr = (const GAS f32x4*)gf + lane;
            const float r = rsqrtf(SS4[m] * (1.0f / D) + 1e-6f);
#pragma unroll
            for (int j = 0; j < 8; ++j) { const f32x4 v = xr[64 * j]; xr[64 * j] = v * r * gr[64 * j]; }
        }
    }
#undef IN
#undef SEAM
}

extern "C" void kernel_launch(void* const* d_in, const int* in_sizes, int n_in, void* d_out, int out_size, void* d_ws, size_t ws_size, hipStream_t stream) {
    static int grid = 0;
    if (grid == 0) {
        if (n_in != 19 || out_size != M * D || ws_size < WS_END) { fprintf(stderr, "kernel_launch: unexpected shapes (n_in %d out %d ws %zu)\n", n_in, out_size, ws_size); grid = -1; return; }
        int dev = 0, cus = 0, per_cu = 0;
        if (hipGetDevice(&dev) != hipSuccess || hipDeviceGetAttribute(&cus, hipDeviceAttributeMultiprocessorCount, dev) != hipSuccess) { grid = -1; return; }
        if (hipFuncSetAttribute((const void*)mega_fwd, hipFuncAttributeMaxDynamicSharedMemorySize, LDS_BYTES) != hipSuccess) { fprintf(stderr, "kernel_launch: hipFuncSetAttribute failed\n"); grid = -1; return; }
        if (hipOccupancyMaxActiveBlocksPerMultiprocessor(&per_cu, (const void*)mega_fwd, NWAVES * 64, LDS_BYTES) != hipSuccess || per_cu < 1) fprintf(stderr, "kernel_launch: occupancy query says %d\n", per_cu);
        (void)hipGetLastError();
        grid = cus;
    }
    if (grid < 0) return;
    (void)hipMemsetAsync((char*)d_ws + WS_CTL, 0, CTL_ZERO_BYTES, stream);
    Args a{};
    for (int i = 0; i < 19; ++i) a.in[i] = (const float*)d_in[i];
    a.out = (float*)d_out; a.ws = (unsigned char*)d_ws;
    unsigned char* ws = (unsigned char*)d_ws;
    auto mega = [&](int lo, int hi, int li) { a.ph_lo = lo; a.ph_hi = hi; a.li = li; hipLaunchKernelGGL(mega_fwd, dim3(grid), dim3(NWAVES * 64), LDS_BYTES, stream, a); };
    auto naive_attn = [&]() {
        const bf16* q6 = (const bf16*)(ws + WS_QKV); const size_t sp = QKV_SPLIT / 2;
        k_da_naive<<<BATCH * DA_HEADS * SEQ / 2, 128, 0, stream>>>(q6, q6 + sp, q6 + 2 * sp, a.in[1], a.in[7], a.in[8], a.in[9], a.in[10], a.in[11], (bf16*)(ws + WS_OA));
        k_sb_naive<<<BATCH * SB_HEADS * SEQ / 4, 256, 0, stream>>>(q6 + 3 * sp, q6 + 4 * sp, q6 + 5 * sp, (bf16*)(ws + WS_OB));
    };
#if MK_MODE == 0
    for (int p = 0; p < N_PHASES; ++p) { if (p == 4) naive_attn(); else mega(p, p + 1, 0); }
#elif MK_MODE == 1
    mega(0, 4, 0); naive_attn(); mega(5, N_PHASES, 1);
#else
    mega(0, N_PHASES, 0);
#endif
}
```

```cpp
#include <hip/hip_runtime.h>
#include <cstdio>
#include <cstdint>
#include <math.h>

namespace pg8 {
#define PG8_LAS __attribute__((address_space(3)))
typedef unsigned short bf16_t;
typedef short bf16x8 __attribute__((ext_vector_type(8)));
typedef float f32x4 __attribute__((ext_vector_type(4)));
typedef unsigned u32x4 __attribute__((ext_vector_type(4)));
constexpr int BM = 256, BK = 64, HALF = 128, HTB = HALF * BK * 2  , STAGE_BYTES = 8 * HTB, NXCD = 8, WGM = 8;

__host__ __device__ __forceinline__ int lds_byte(int r, int c) { const int st = (r >> 4) * 2 + (c >> 5), rr = r & 15, cc = c & 31, ob = rr * 64 + cc * 2; return st * 1024 + (ob ^ (((ob >> 9) & 1) << 5)); }
__host__ __device__ __forceinline__ void stage_rc(int b, int& R, int& C) { const int st = b / 1024, sb = b % 1024, swz = sb ^ (((sb >> 9) & 1) << 5); R = (st >> 1) * 16 + swz / 64; C = (st & 1) * 32 + (swz % 64) / 2; }
__host__ __device__ __forceinline__ int perm32(int rho) { const int n = rho >> 4, i = rho & 15; return 8 * (i >> 2) + 4 * n + (i & 3); }

struct Unit { int pm, pn; };
struct Gemm { const bf16_t* A; const bf16_t* Bt; int M, N, K; };

struct StaticOrder {
    int nM, nN, nwg, G, c;
    __host__ __device__ void init(int M, int N, int G_, int c_) { nM = M / BM; nN = N / BM; nwg = nM * nN; G = G_; c = c_; }
    __host__ __device__ bool next(int i, Unit& u) const {
        const long L = (long)i * G + c; if (L >= nwg) return false;
        int wgid = (int)L; { const int q = nwg / NXCD, r = nwg % NXCD, xcd = wgid % NXCD, off = wgid / NXCD; wgid = (xcd < r ? xcd * (q + 1) : r * (q + 1) + (xcd - r) * q) + off; }
        const int nig = WGM * nN, gid = wgid / nig, fm = gid * WGM, gsz = (nM - fm) < WGM ? (nM - fm) : WGM;
        u.pm = fm + ((wgid % nig) % gsz); u.pn = (wgid % nig) / gsz; return true;
    }
    __device__ __forceinline__ void a_ready(const Unit&) const {}
    __device__ __forceinline__ void done(const Unit&) const {}
};
__device__ __forceinline__ unsigned cvt_pk_bf16(float lo, float hi) { unsigned r; asm volatile("v_cvt_pk_bf16_f32 %0, %1, %2" : "=v"(r) : "v"(lo), "v"(hi)); return r; }
typedef float f32x2 __attribute__((ext_vector_type(2)));
constexpr float RMS_EPS = 1e-6f, LOG2E = 1.4426950408889634f;
__device__ __forceinline__ float rstd_of(float ss) { return rsqrtf(ss * (1.0f / 2048.0f) + RMS_EPS); }
__device__ __forceinline__ float sigm(float g) { return __builtin_amdgcn_rcpf(1.0f + __builtin_amdgcn_exp2f(-LOG2E * g)); }
__device__ __forceinline__ u32x4 pack8(const f32x4& a, const f32x4& b) { u32x4 w; w.x = cvt_pk_bf16(a[0], a[1]); w.y = cvt_pk_bf16(a[2], a[3]); w.z = cvt_pk_bf16(b[0], b[1]); w.w = cvt_pk_bf16(b[2], b[3]); return w; }
__device__ __forceinline__ float bflo(unsigned w) { return __uint_as_float(w << 16); }
__device__ __forceinline__ float bfhi(unsigned w) { return __uint_as_float(w & 0xffff0000u); }
template <bool SSQ> struct EpiSwiGLU {
    static constexpr bool PERM = true, AFTER_DRAIN = false;
    bf16_t* H; const float* rs;
    __device__ __forceinline__ void operator()(const f32x4 (&acc)[2][2][4][2], const Unit& u, int wr, int wc, int fr, int fq) const {
        const int row0 = u.pm * BM + wr * 64 + fr, col0 = u.pn * 128 + wc * 32 + 8 * fq;
#pragma unroll
        for (int ai = 0; ai < 2; ++ai)
#pragma unroll
            for (int m = 0; m < 4; ++m) {
                const int row = row0 + ai * HALF + m * 16;
                float r = rs[row]; if (SSQ) r = rstd_of(r);
                f32x4 h0, h1;
#pragma unroll
                for (int e = 0; e < 4; ++e) {
                    const float g0 = acc[ai][0][m][0][e] * r, g1 = acc[ai][0][m][1][e] * r;
                    h0[e] = g0 * sigm(g0) * (acc[ai][1][m][0][e] * r); h1[e] = g1 * sigm(g1) * (acc[ai][1][m][1][e] * r);
                }
                *(u32x4*)(H + (size_t)row * 5632 + col0) = pack8(h0, h1);
            }
    }
};
template <bool WRITE_BF16> struct EpiResid {
    static constexpr bool PERM = true, AFTER_DRAIN = false;
    const float* xin; float* xout; bf16_t* xb; float* ss; float alpha;
    __device__ __forceinline__ void operator()(const f32x4 (&acc)[2][2][4][2], const Unit& u, int wr, int wc, int fr, int fq) const {
        const int row0 = u.pm * BM + wr * 64 + fr, col0 = u.pn * BM + wc * 32 + 8 * fq;
#pragma unroll
        for (int ai = 0; ai < 2; ++ai)
#pragma unroll
            for (int m = 0; m < 4; ++m) {
                const int row = row0 + ai * HALF + m * 16; const size_t off = (size_t)row * 2048 + col0; float sq = 0.f;
#pragma unroll
                for (int bj = 0; bj < 2; ++bj) {
                    const f32x4 a0 = *(const f32x4*)(xin + off + bj * HALF), a1 = *(const f32x4*)(xin + off + bj * HALF + 4);
                    const f32x4 o0 = a0 + acc[ai][bj][m][0] * alpha, o1 = a1 + acc[ai][bj][m][1] * alpha;
                    *(f32x4*)(xout + off + bj * HALF) = o0; *(f32x4*)(xout + off + bj * HALF + 4) = o1;
                    sq += (o0[0] * o0[0] + o0[1] * o0[1]) + (o0[2] * o0[2] + o0[3] * o0[3]) + (o1[0] * o1[0] + o1[1] * o1[1]) + (o1[2] * o1[2] + o1[3] * o1[3]);
                    if (WRITE_BF16) *(u32x4*)(xb + off + bj * HALF) = pack8(o0, o1);
                }
                sq += __shfl_xor(sq, 16); sq += __shfl_xor(sq, 32);
                if (fq == 0) atomicAdd(ss + row, sq);
                if (m & 1) asm volatile("" ::: "memory");
            }
    }
};
struct EpiQKV {
    static constexpr bool PERM = true, AFTER_DRAIN = false;
    bf16_t* base; size_t split; const float* ss; float qscale;
    __device__ __forceinline__ void operator()(const f32x4 (&acc)[2][2][4][2], const Unit& u, int wr, int wc, int fr, int fq) const {
        const int row0 = u.pm * BM + wr * 64 + fr; int colt = u.pn * BM; const int t = colt / 1024; colt -= t * 1024;
        bf16_t* ob = base + (size_t)t * split; const float sc = (t == 0 || t == 3) ? qscale : 1.0f; const int col0 = colt + wc * 32 + 8 * fq;
#pragma unroll
        for (int ai = 0; ai < 2; ++ai)
#pragma unroll
            for (int m = 0; m < 4; ++m) {
                const int row = row0 + ai * HALF + m * 16; const float r = rstd_of(ss[row]) * sc;
#pragma unroll
                for (int bj = 0; bj < 2; ++bj) *(u32x4*)(ob + (size_t)row * 1024 + col0 + bj * HALF) = pack8(acc[ai][bj][m][0] * r, acc[ai][bj][m][1] * r);
            }
    }
};
struct EpiGate {
    static constexpr bool PERM = true, AFTER_DRAIN = false;
    bf16_t* G; const float* ss;
    __device__ __forceinline__ void operator()(const f32x4 (&acc)[2][2][4][2], const Unit& u, int wr, int wc, int fr, int fq) const {
        const int row0 = u.pm * BM + wr * 64 + fr, col0 = u.pn * BM + wc * 32 + 8 * fq;
#pragma unroll
        for (int ai = 0; ai < 2; ++ai)
#pragma unroll
            for (int m = 0; m < 4; ++m) {
                const int row = row0 + ai * HALF + m * 16; const float r = rstd_of(ss[row]);
#pragma unroll
                for (int bj = 0; bj < 2; ++bj) { f32x4 s0, s1;
#pragma unroll
                    for (int e = 0; e < 4; ++e) { s0[e] = sigm(acc[ai][bj][m][0][e] * r); s1[e] = sigm(acc[ai][bj][m][1][e] * r); }
                    *(u32x4*)(G + (size_t)row * 2048 + col0 + bj * HALF) = pack8(s0, s1); }
            }
    }
};
template <bool FIRST> struct EpiBranch {
    static constexpr bool PERM = true, AFTER_DRAIN = false;
    const bf16_t* G; float* T; bf16_t* MG;
    __device__ __forceinline__ void operator()(const f32x4 (&acc)[2][2][4][2], const Unit& u, int wr, int wc, int fr, int fq) const {
        const int row0 = u.pm * BM + wr * 64 + fr, col0 = u.pn * BM + wc * 32 + 8 * fq;
#pragma unroll
        for (int ai = 0; ai < 2; ++ai)
#pragma unroll
            for (int m = 0; m < 4; ++m) {
                const int row = row0 + ai * HALF + m * 16;
#pragma unroll
                for (int bj = 0; bj < 2; ++bj) { const size_t off = (size_t)row * 2048 + col0 + bj * HALF;
                    const u32x4 g = *(const u32x4*)(G + off);
                    f32x4 o0, o1;
                    o0[0] = bflo(g.x) * acc[ai][bj][m][0][0]; o0[1] = bfhi(g.x) * acc[ai][bj][m][0][1]; o0[2] = bflo(g.y) * acc[ai][bj][m][0][2]; o0[3] = bfhi(g.y) * acc[ai][bj][m][0][3];
                    o1[0] = bflo(g.z) * acc[ai][bj][m][1][0]; o1[1] = bfhi(g.z) * acc[ai][bj][m][1][1]; o1[2] = bflo(g.w) * acc[ai][bj][m][1][2]; o1[3] = bfhi(g.w) * acc[ai][bj][m][1][3];
                    if (FIRST) { *(f32x4*)(T + off) = o0; *(f32x4*)(T + off + 4) = o1; }
                    else { o0 += *(const f32x4*)(T + off); o1 += *(const f32x4*)(T + off + 4); *(u32x4*)(MG + off) = pack8(o0, o1); } }
                if (m & 1) asm volatile("" ::: "memory");
            }
    }
};


template <class Epi, class Sched, bool ALIGN_EPI = false, bool SP2 = false>
__device__ __forceinline__ void gemm_phase(PG8_LAS unsigned char* lds, const Gemm g, const Sched& S, const Epi& E) {
    const int tid = threadIdx.x, wid = __builtin_amdgcn_readfirstlane(tid >> 6), lane = tid & 63, wr = wid >> 2, wc = wid & 3, fr = lane & 15, fq = lane >> 4;
    const int K = g.K, nt = K / BK;
    unsigned voffA[2], voffB[2];
#pragma unroll
    for (int i = 0; i < 2; ++i) { int R, C; stage_rc(tid * 16 + i * 8192, R, C); const int Rb = Epi::PERM ? ((R & ~31) + perm32(R & 31)) : R;
        voffA[i] = (unsigned)(R * K + C) * 2u; voffB[i] = (unsigned)(Rb * K + C) * 2u; }
    const size_t kstep = (size_t)(BK * 2);
    const size_t hstep = (size_t)HALF * K * 2;
    const size_t tstep = 2 * hstep;
    const unsigned ldsw = (unsigned)wid * 1024u;
    const int aoff = lds_byte(wr * 64 + fr, fq * 8), boff = lds_byte(wc * 32 + fr, fq * 8);
#define PG8_SA(b, h) (((b) * 2 + (h)) * HTB)
#define PG8_SB(b, h) ((4 + (b) * 2 + (h)) * HTB)
#define PG8_STAGE(bufoff, gbase, voff) do { _Pragma("unroll") for (int _i = 0; _i < 2; ++_i) \
        __builtin_amdgcn_global_load_lds((const unsigned*)((const char*)(gbase) + (voff)[_i]), (PG8_LAS unsigned*)(lds + (bufoff) + ldsw + _i * 8192), 16, 0, 0); } while (0)
#define PG8_LDA(dst, b, h) do { _Pragma("unroll") for (int m = 0; m < 4; ++m) _Pragma("unroll") for (int k = 0; k < 2; ++k) dst[m][k] = *(const PG8_LAS bf16x8*)(lds + PG8_SA(b, h) + aoff + m * 2048 + k * 1024); } while (0)
#define PG8_LDB(dst, b, h) do { _Pragma("unroll") for (int n = 0; n < 2; ++n) _Pragma("unroll") for (int k = 0; k < 2; ++k) dst[n][k] = *(const PG8_LAS bf16x8*)(lds + PG8_SB(b, h) + boff + n * 2048 + k * 1024); } while (0)
#define PG8_MMA(ai, bj, At, Bt) do { __builtin_amdgcn_s_setprio(1); _Pragma("unroll") for (int m = 0; m < 4; ++m) _Pragma("unroll") for (int n = 0; n < 2; ++n) _Pragma("unroll") for (int k = 0; k < 2; ++k) \
        acc[ai][bj][m][n] = __builtin_amdgcn_mfma_f32_16x16x32_bf16(Bt[n][k], At[m][k], acc[ai][bj][m][n], 0, 0, 0); __builtin_amdgcn_s_setprio(0); } while (0)
#define PG8_WAIT_V(n) asm volatile("s_waitcnt vmcnt(" #n ")" ::: "memory")
#define PG8_WAIT_L(n) asm volatile("s_waitcnt lgkmcnt(" #n ")" ::: "memory")
#define PG8_BAR __builtin_amdgcn_s_barrier()
#define PG8_SCHED __builtin_amdgcn_sched_barrier(0)
    Unit cur, nxt; int ui = 0;
    if (!S.next(0, cur)) return;
    f32x4 acc[2][2][4][2];
#pragma unroll
    for (int a = 0; a < 2; ++a)
#pragma unroll
        for (int b = 0; b < 2; ++b)
#pragma unroll
            for (int m = 0; m < 4; ++m)
#pragma unroll
                for (int n = 0; n < 2; ++n) acc[a][b][m][n] = (f32x4){0.f, 0.f, 0.f, 0.f};
    bf16x8 At[4][2], B0[2][2], B1[2][2];
    const char* cA = (const char*)g.A + (size_t)cur.pm * tstep; const char* cB = (const char*)g.Bt + (size_t)cur.pn * tstep;
    S.a_ready(cur);
    if constexpr (SP2) {
        PG8_STAGE(PG8_SB(0, 0), cB, voffB); PG8_STAGE(PG8_SB(0, 1), cB + hstep, voffB); PG8_STAGE(PG8_SA(0, 0), cA, voffA); PG8_STAGE(PG8_SA(0, 1), cA + hstep, voffA);
        if (wr == 1) PG8_BAR;
        PG8_WAIT_V(2); PG8_BAR;
        PG8_STAGE(PG8_SB(1, 0), cB + kstep, voffB); PG8_STAGE(PG8_SA(1, 0), cA + kstep, voffA); PG8_STAGE(PG8_SB(1, 1), cB + hstep + kstep, voffB);
        PG8_WAIT_V(6); PG8_BAR;
    } else {
        PG8_STAGE(PG8_SB(0, 0), cB, voffB); PG8_STAGE(PG8_SA(0, 0), cA, voffA); PG8_STAGE(PG8_SB(0, 1), cB + hstep, voffB); PG8_STAGE(PG8_SA(0, 1), cA + hstep, voffA);
        if (wr == 1) PG8_BAR;
        PG8_WAIT_V(4); PG8_BAR;
        PG8_STAGE(PG8_SB(1, 0), cB + kstep, voffB); PG8_STAGE(PG8_SA(1, 0), cA + kstep, voffA); PG8_STAGE(PG8_SB(1, 1), cB + hstep + kstep, voffB);
        PG8_WAIT_V(6); PG8_BAR;
    }
    for (;;) {
        const bool has_next = S.next(ui + 1, nxt);
        const char* nA = has_next ? (const char*)g.A + (size_t)nxt.pm * tstep : cA; const char* nB = has_next ? (const char*)g.Bt + (size_t)nxt.pn * tstep : cB;
        for (int t = 0; t < nt; t += 2) {
            const bool last = (t == nt - 2);
            const char* a1 = cA + (size_t)(t + 1) * kstep;
            const char* a2 = last ? nA : cA + (size_t)(t + 2) * kstep; const char* b2 = last ? nB : cB + (size_t)(t + 2) * kstep;
            const char* a3 = a2 + kstep; const char* b3 = b2 + kstep;
            if (last && has_next) S.a_ready(nxt);
            if constexpr (SP2) {
            PG8_LDB(B0, 0, 0); PG8_LDB(B1, 0, 1); PG8_SCHED; PG8_LDA(At, 0, 0); PG8_STAGE(PG8_SA(1, 1), a1 + hstep, voffA);
            PG8_WAIT_V(8); PG8_WAIT_L(0); PG8_BAR; PG8_MMA(0, 0, At, B0); PG8_MMA(0, 1, At, B1); PG8_BAR; PG8_SCHED;
            PG8_LDA(At, 0, 1); PG8_STAGE(PG8_SB(0, 0), b2, voffB); PG8_STAGE(PG8_SB(0, 1), b2 + hstep, voffB); PG8_STAGE(PG8_SA(0, 0), a2, voffA);
            PG8_WAIT_V(8); PG8_WAIT_L(0); PG8_BAR; PG8_MMA(1, 0, At, B0); PG8_MMA(1, 1, At, B1); PG8_BAR; PG8_SCHED;
            PG8_LDB(B0, 1, 0); PG8_LDB(B1, 1, 1); PG8_SCHED; PG8_LDA(At, 1, 0); PG8_STAGE(PG8_SA(0, 1), a2 + hstep, voffA);
            PG8_WAIT_V(8); PG8_WAIT_L(0); PG8_BAR; PG8_MMA(0, 0, At, B0); PG8_MMA(0, 1, At, B1); PG8_BAR; PG8_SCHED;
            PG8_LDA(At, 1, 1); PG8_STAGE(PG8_SB(1, 0), b3, voffB); PG8_STAGE(PG8_SB(1, 1), b3 + hstep, voffB); PG8_STAGE(PG8_SA(1, 0), a3, voffA);
            PG8_WAIT_V(8); PG8_WAIT_L(0); PG8_BAR; PG8_MMA(1, 0, At, B0); PG8_MMA(1, 1, At, B1); PG8_BAR; PG8_SCHED;
            } else {
            PG8_LDB(B0, 0, 0); PG8_SCHED; PG8_LDA(At, 0, 0); PG8_STAGE(PG8_SA(1, 1), a1 + hstep, voffA);
            PG8_WAIT_L(8); PG8_BAR; PG8_WAIT_L(0); PG8_MMA(0, 0, At, B0); PG8_BAR; PG8_SCHED;
            PG8_LDB(B1, 0, 1); PG8_STAGE(PG8_SB(0, 0), b2, voffB);
            PG8_BAR; PG8_WAIT_L(0); PG8_MMA(0, 1, At, B1); PG8_BAR;
            PG8_LDA(At, 0, 1); PG8_STAGE(PG8_SA(0, 0), a2, voffA);
            PG8_BAR; PG8_WAIT_L(0); PG8_MMA(1, 0, At, B0); PG8_BAR; PG8_SCHED;
            PG8_STAGE(PG8_SB(0, 1), b2 + hstep, voffB);
            PG8_WAIT_V(6); PG8_BAR; PG8_MMA(1, 1, At, B1); PG8_BAR;
            PG8_LDB(B0, 1, 0); PG8_SCHED; PG8_LDA(At, 1, 0); PG8_STAGE(PG8_SA(0, 1), a2 + hstep, voffA);
            PG8_WAIT_L(8); PG8_BAR; PG8_WAIT_L(0); PG8_MMA(0, 0, At, B0); PG8_BAR; PG8_SCHED;
            PG8_LDB(B1, 1, 1); PG8_STAGE(PG8_SB(1, 0), b3, voffB);
            PG8_BAR; PG8_WAIT_L(0); PG8_MMA(0, 1, At, B1); PG8_BAR;
            PG8_LDA(At, 1, 1); PG8_STAGE(PG8_SA(1, 0), a3, voffA);
            PG8_BAR; PG8_WAIT_L(0); PG8_MMA(1, 0, At, B0); PG8_BAR; PG8_SCHED;
            PG8_STAGE(PG8_SB(1, 1), b3 + hstep, voffB);
            PG8_WAIT_V(6); PG8_BAR; PG8_MMA(1, 1, At, B1); PG8_BAR;
            }
        }
        if constexpr (ALIGN_EPI) { if (wr == 0) PG8_BAR; }
        if constexpr (!Epi::AFTER_DRAIN) { E(acc, cur, wr, wc, fr, fq); S.done(cur); }
        if (!has_next) break;
#pragma unroll
        for (int a = 0; a < 2; ++a)
#pragma unroll
            for (int b = 0; b < 2; ++b)
#pragma unroll
                for (int m = 0; m < 4; ++m)
#pragma unroll
                    for (int n = 0; n < 2; ++n) acc[a][b][m][n] = (f32x4){0.f, 0.f, 0.f, 0.f};
        cur = nxt; cA = nA; cB = nB; ++ui;
        if constexpr (ALIGN_EPI) { if (wr == 1) PG8_BAR; }
    }
    PG8_WAIT_V(0);
    if constexpr (!ALIGN_EPI) { if (wr == 0) PG8_BAR; }
    PG8_BAR;
    if constexpr (Epi::AFTER_DRAIN) { E.fused(acc, cur, wr, wc, fr, fq, lds, wid, lane); S.done(cur); }
#undef PG8_SA
#undef PG8_SB
#undef PG8_STAGE
#undef PG8_LDA
#undef PG8_LDB
#undef PG8_MMA
#undef PG8_WAIT_V
#undef PG8_WAIT_L
#undef PG8_BAR
#undef PG8_SCHED
}
}
#ifndef PG8_SP2
#define PG8_SP2 true
#endif
#ifndef PG8_ALIGN
#define PG8_ALIGN true
#endif
constexpr int NWAVES = 8;
#ifndef MK_MODE
#define MK_MODE 2
#endif
constexpr int BATCH = 4, SEQ = 2048, D = 2048, M = BATCH * SEQ, FF = 5632, NIN = 10240;
constexpr int DA_HEADS = 8, SB_HEADS = 16;
constexpr float SUBLN_EPS = 1e-5f, LAMBDA_INIT = 0.2f;
constexpr float C2 = 0.125f * 1.4426950408889634f;
constexpr size_t MiB = 1u << 20;
constexpr size_t WS_CTL = 0, CTL_ZERO_BYTES = 1 * MiB;
constexpr size_t WS_WGU1 = 2 * MiB, WS_WD1 = 46 * MiB, WS_WIN = 68 * MiB, WS_WA = 108 * MiB, WS_WB = 112 * MiB, WS_WOUT = 116 * MiB, WS_WGU2 = 124 * MiB, WS_WD2 = 168 * MiB;
constexpr size_t WS_XB = 190 * MiB;
constexpr size_t WS_H = 222 * MiB;
constexpr size_t WS_OA = 222 * MiB, WS_OB = 238 * MiB, WS_MG = 254 * MiB;
constexpr size_t WS_QKV = 310 * MiB, QKV_SPLIT = 16 * MiB;
constexpr size_t WS_G = 310 * MiB, WS_T = 342 * MiB;
constexpr size_t WS_END = 406 * MiB;
constexpr int CW_BAR = 4096;
constexpr int CW_SS2 = 32768, CW_SS3 = CW_SS2 + M, CW_SS4 = CW_SS3 + M, CW_RS1 = CW_SS4 + M;
static_assert((CW_RS1 + M) * 4 <= (int)CTL_ZERO_BYTES, "CTL words inside the memset region");
constexpr int RING_OFF = 0, RING_BYTES = 131072;
constexpr int LDSCTL_OFF = RING_BYTES, MISC_OFF = LDSCTL_OFF + 320;
constexpr int LDS_BYTES = 147456;

#define GAS __attribute__((address_space(1)))
#define LAS __attribute__((address_space(3)))
typedef unsigned short bf16;
typedef unsigned v4u __attribute__((ext_vector_type(4)));
typedef float f32x4 __attribute__((ext_vector_type(4)));
typedef short bf16x8 __attribute__((ext_vector_type(8)));
typedef GAS unsigned gu32;
typedef GAS unsigned long long gu64;
#define RLX_AGENT __ATOMIC_RELAXED, __HIP_MEMORY_SCOPE_AGENT
#define LDS_WAIT() asm volatile("s_waitcnt lgkmcnt(0)" ::: "memory")
#define VM_WAIT() asm volatile("s_waitcnt vmcnt(0)" ::: "memory")
__device__ __forceinline__ unsigned long long rt() { return __builtin_amdgcn_s_memrealtime(); }
__device__ __forceinline__ unsigned f2bf(float f) { unsigned u = __builtin_bit_cast(unsigned, f); return (u + 0x7fffu + ((u >> 16) & 1u)) >> 16; }
__device__ __forceinline__ unsigned pk2(float lo, float hi) { return f2bf(lo) | (f2bf(hi) << 16); }
#define XB_TMO      128
#define XB_XCNT(j)  (256  + 64 * (j))
#define XB_XSUB(j)  (1280 + 64 * (j))
#define XB_XGEN(j)  (2304 + 64 * (j))
#define XB_TOP      3328
#define XB_TOPGEN   3392
#define XCD_BAR_WORDS 3456
#define XB_SPIN_CAP (1u << 18)

__device__ __forceinline__ unsigned xb_ld(unsigned* p)              { return __hip_atomic_load(p, __ATOMIC_RELAXED, __HIP_MEMORY_SCOPE_AGENT); }
__device__ __forceinline__ unsigned xb_add(unsigned* p, unsigned v) { return __hip_atomic_fetch_add(p, v, __ATOMIC_RELAXED, __HIP_MEMORY_SCOPE_AGENT); }
__device__ __forceinline__ unsigned xb_xcc_id() { return (unsigned)__builtin_amdgcn_s_getreg((3 << 11) | 20) & 0xFu; }
#define XB_SPIN(cond, bar) do { unsigned _sp = 0; while (cond) { __builtin_amdgcn_s_sleep(1); \
    if ((++_sp & 255u) == 0u) { if (xb_ld(&(bar)[XB_TMO])) break; if (_sp > XB_SPIN_CAP) { atomicAdd(&(bar)[XB_TMO], 1u); break; } } } } while (0)

struct XcdBarrier {
    unsigned* bar; unsigned x;
    volatile LAS unsigned* st;
};

__device__ __forceinline__ XcdBarrier xcd_barrier_post(unsigned* bar, volatile LAS unsigned* st) {
    XcdBarrier b; b.bar = bar; b.x = xb_xcc_id(); b.st = st;
    if (threadIdx.x == 0) (void)xb_add(&bar[XB_XCNT(b.x)], 1u);
    return b;
}
__device__ __forceinline__ void xcd_barrier_complete(unsigned* bar, unsigned x, unsigned& nloc, unsigned& nx) {
    const unsigned G = gridDim.x * gridDim.y * gridDim.z;
    unsigned sum, cnt, mine, sp = 0u;
    for (;;) {
        sum = 0u; cnt = 0u; mine = 0u;
#pragma unroll
        for (unsigned j = 0; j < 16; ++j) { const unsigned c = xb_ld(&bar[XB_XCNT(j)]); sum += c; cnt += (c > 0u) ? 1u : 0u; mine = (j == x) ? c : mine; }
        if (sum == G) break;
        __builtin_amdgcn_s_sleep(1);
        if ((++sp & 255u) == 0u) { if (xb_ld(&bar[XB_TMO])) break; if (sp > XB_SPIN_CAP) { atomicAdd(&bar[XB_TMO], 1u); break; } }
    }
    nloc = mine > 0u ? mine : 1u; nx = cnt > 0u ? cnt : 1u;
}

__device__ __forceinline__ void xcd_barrier(const XcdBarrier& b) {
    asm volatile("s_waitcnt vmcnt(0)" ::: "memory");
    __syncthreads();
    if (threadIdx.x == 0) {
        unsigned* bar = b.bar;
        __builtin_amdgcn_s_waitcnt(0);
        unsigned nloc = b.st[0], nx = b.st[1];
        if (nloc == 0u) { xcd_barrier_complete(bar, b.x, nloc, nx); b.st[0] = nloc; b.st[1] = nx; }
        const unsigned old = xb_add(&bar[XB_XSUB(b.x)], 1u);
        const unsigned gen = old / nloc;
        if (old + 1u == (gen + 1u) * nloc) {
            __builtin_amdgcn_fence(__ATOMIC_RELEASE, "agent");
            asm volatile("s_waitcnt vmcnt(0)" ::: "memory");
            const unsigned og = xb_add(&bar[XB_TOP], 1u);
            const unsigned tg = og / nx;
            if (og + 1u == (tg + 1u) * nx) xb_add(&bar[XB_TOPGEN], 1u);
            else XB_SPIN(xb_ld(&bar[XB_TOPGEN]) == tg, bar);
            __builtin_amdgcn_fence(__ATOMIC_ACQUIRE, "agent");
            xb_add(&bar[XB_XGEN(b.x)], 1u);
            asm volatile("s_waitcnt vmcnt(0)" ::: "memory");
        } else {
            XB_SPIN(xb_ld(&bar[XB_XGEN(b.x)]) == gen, bar);
            __builtin_amdgcn_fence(__ATOMIC_ACQUIRE, "agent");
            asm volatile("s_waitcnt vmcnt(0)" ::: "memory");
        }
    }
    __syncthreads();
}
__device__ __forceinline__ float wave_sum(float v) {
#pragma unroll
    for (int o = 1; o < 64; o <<= 1) v += __shfl_xor(v, o);
    return v;
}
__device__ __forceinline__ float wave_max(float v) {
#pragma unroll
    for (int o = 1; o < 64; o <<= 1) v = fmaxf(v, __shfl_xor(v, o));
    return v;
}
typedef float f32x2_t __attribute__((ext_vector_type(2))); typedef __bf16 bf16x2_t __attribute__((ext_vector_type(2)));
__device__ __forceinline__ unsigned cvtpk(float lo, float hi) { f32x2_t v = {lo, hi}; bf16x2_t b = __builtin_convertvector(v, bf16x2_t); return __builtin_bit_cast(unsigned, b); }
template <bool GU>
__device__ __forceinline__ void p0_convert_item(const float* W, int K, int N, const float* gain, bf16* WT, int item, int lane) {
    const int nblk = N / 64, kb = item / nblk, nb = item % nblk, k0 = 64 * kb, n0 = 64 * nb;
    const int a = lane & 15, g = lane >> 4;
    const f32x4* src = (const f32x4*)(W + (size_t)(k0 + 16 * g) * N + n0 + 4 * a);
    f32x4 v[16];
#pragma unroll
    for (int i = 0; i < 16; ++i) v[i] = __builtin_nontemporal_load(src + (size_t)i * (N / 4));
    if (gain) {
        const f32x4* gp = (const f32x4*)(gain + k0 + 16 * g);
#pragma unroll
        for (int j = 0; j < 4; ++j) { const f32x4 gv = gp[j]; v[4 * j] *= gv[0]; v[4 * j + 1] *= gv[1]; v[4 * j + 2] *= gv[2]; v[4 * j + 3] *= gv[3]; }
    }
    int r0 = n0; if (GU) { r0 = (n0 < FF) ? (256 * (n0 / 128) + n0 % 128) : (256 * ((n0 - FF) / 128) + 128 + (n0 - FF) % 128); }
#pragma unroll
    for (int e = 0; e < 4; ++e) {
        v4u o0, o1;
        o0.x = cvtpk(v[0][e], v[1][e]); o0.y = cvtpk(v[2][e], v[3][e]); o0.z = cvtpk(v[4][e], v[5][e]); o0.w = cvtpk(v[6][e], v[7][e]);
        o1.x = cvtpk(v[8][e], v[9][e]); o1.y = cvtpk(v[10][e], v[11][e]); o1.z = cvtpk(v[12][e], v[13][e]); o1.w = cvtpk(v[14][e], v[15][e]);
        v4u* dst = (v4u*)(WT + (size_t)(r0 + 4 * a + e) * K + k0 + 16 * g); dst[0] = o0; dst[1] = o1;
    }
}

__device__ __forceinline__ int rel_bucket(int rel) {
    const int ret = rel > 0 ? 16 : 0; const int n = rel < 0 ? -rel : rel;
    int b;
    if (n < 8) b = n; else if (n < 12) b = 8; else if (n < 16) b = 9; else if (n < 23) b = 10; else if (n < 32) b = 11; else if (n < 46) b = 12; else if (n < 64) b = 13; else if (n < 91) b = 14; else b = 15;
    return ret + b;
}
__device__ __forceinline__ float bf2f(bf16 b) { return __uint_as_float(((unsigned)b) << 16); }
__global__ __launch_bounds__(128) void k_da_naive(const bf16* __restrict__ DQ, const bf16* __restrict__ DK, const bf16* __restrict__ DV, const float* __restrict__ rel_bias,
                                                  const float* lq1, const float* lk1, const float* lq2, const float* lk2, const float* subln, bf16* OA) {
    __shared__ float sS[2][2][SEQ];
    __shared__ float sQ[2][128];
    const int tid = threadIdx.x, w = tid >> 6, lane = tid & 63;
    const int gq = blockIdx.x * 2 + w; const int q = gq % SEQ, bh = gq / SEQ, h = bh % DA_HEADS, b = bh / DA_HEADS;
    const size_t m = (size_t)b * SEQ + q;
    sQ[w][lane] = bf2f(DQ[m * 1024 + h * 128 + lane]); sQ[w][lane + 64] = bf2f(DQ[m * 1024 + h * 128 + 64 + lane]);
    const float lam = __expf(wave_sum(lq1[lane] * lk1[lane])) - __expf(wave_sum(lq2[lane] * lk2[lane])) + LAMBDA_INIT;
    __syncthreads();
    const int nk = (q / 64 + 1) * 64;
    float mx0 = -INFINITY, mx1 = -INFINITY;
    for (int k = lane; k < nk; k += 64) {
        const bf16* kr = DK + ((size_t)b * SEQ + k) * 1024 + h * 128;
        float s0 = 0.f, s1 = 0.f;
#pragma unroll
        for (int c = 0; c < 8; ++c) {
            const uint4 v0 = *(const uint4*)(kr + c * 8), v1 = *(const uint4*)(kr + 64 + c * 8);
            const unsigned a0[4] = {v0.x, v0.y, v0.z, v0.w}, a1[4] = {v1.x, v1.y, v1.z, v1.w};
#pragma unroll
            for (int e = 0; e < 4; ++e) {
                s0 += sQ[w][c * 8 + 2 * e] * __uint_as_float(a0[e] << 16) + sQ[w][c * 8 + 2 * e + 1] * __uint_as_float(a0[e] & 0xffff0000u);
                s1 += sQ[w][64 + c * 8 + 2 * e] * __uint_as_float(a1[e] << 16) + sQ[w][64 + c * 8 + 2 * e + 1] * __uint_as_float(a1[e] & 0xffff0000u);
            }
        }
        const int bk = rel_bucket(k - q);
        s0 = s0 + 1.4426950408889634f * rel_bias[bk * 16 + h * 2 + 0]; s1 = s1 + 1.4426950408889634f * rel_bias[bk * 16 + h * 2 + 1];
        sS[w][0][k] = s0; sS[w][1][k] = s1; mx0 = fmaxf(mx0, s0); mx1 = fmaxf(mx1, s1);
    }
    mx0 = wave_max(mx0); mx1 = wave_max(mx1);
    float l0 = 0.f, l1 = 0.f;
    for (int k = lane; k < nk; k += 64) { const float p0 = exp2f(sS[w][0][k] - mx0), p1 = exp2f(sS[w][1][k] - mx1); sS[w][0][k] = p0; sS[w][1][k] = p1; l0 += p0; l1 += p1; }
    l0 = wave_sum(l0); l1 = wave_sum(l1);
    const float i0 = 1.0f / l0, i1 = lam / l1;
    for (int k = lane; k < nk; k += 64) sS[w][0][k] = sS[w][0][k] * i0 - sS[w][1][k] * i1;
    __syncthreads();
    float o0 = 0.f, o1 = 0.f;
    const bf16* vb = DV + (size_t)b * SEQ * 1024 + h * 128 + 2 * lane;
    for (int k = 0; k < nk; ++k) { const float a = sS[w][0][k]; const unsigned vv = *(const unsigned*)(vb + (size_t)k * 1024); o0 += a * __uint_as_float(vv << 16); o1 += a * __uint_as_float(vv & 0xffff0000u); }
    const float ss = wave_sum(o0 * o0 + o1 * o1);
    const float r = rsqrtf(ss * (1.0f / 128.0f) + SUBLN_EPS) * (1.0f - LAMBDA_INIT);
    *(unsigned*)(OA + m * 1024 + h * 128 + 2 * lane) = pk2(o0 * r * subln[2 * lane], o1 * r * subln[2 * lane + 1]);
}
__global__ __launch_bounds__(256) void k_sb_naive(const bf16* __restrict__ SQ, const bf16* __restrict__ SK, const bf16* __restrict__ SV, bf16* OB) {
    __shared__ float sW[4][SEQ];
    __shared__ float sQ[4][64];
    const int tid = threadIdx.x, w = tid >> 6, lane = tid & 63;
    const int gq = blockIdx.x * 4 + w; const int q = gq % SEQ, bh = gq / SEQ, h = bh % SB_HEADS, b = bh / SB_HEADS;
    const size_t m = (size_t)b * SEQ + q;
    sQ[w][lane] = bf2f(SQ[m * 1024 + h * 64 + lane]);
    __syncthreads();
    const int nchunk = (q + 63) / 64;
    float carry = 0.f;
    for (int c = nchunk - 1; c >= 0; --c) {
        const int j = c * 64 + lane; const bool valid = j < q;
        const bf16* kr = SK + ((size_t)b * SEQ + j) * 1024 + h * 64;
        float z = 0.f;
#pragma unroll
        for (int cc = 0; cc < 8; ++cc) {
            const uint4 v0 = *(const uint4*)(kr + cc * 8); const unsigned a0[4] = {v0.x, v0.y, v0.z, v0.w};
#pragma unroll
            for (int e = 0; e < 4; ++e) z += sQ[w][cc * 8 + 2 * e] * __uint_as_float(a0[e] << 16) + sQ[w][cc * 8 + 2 * e + 1] * __uint_as_float(a0[e] & 0xffff0000u);
        }
        z *= 0.6931471805599453f;
        const float sp = fmaxf(z, 0.f) + log1pf(__expf(-fabsf(z)));
        const float lk = valid ? -sp : 0.f;
        float incl = lk;
#pragma unroll
        for (int off = 1; off < 64; off <<= 1) { const float t = __shfl_down(incl, off); incl += (lane + off < 64) ? t : 0.f; }
        const float lb = carry + incl - lk;
        sW[w][j] = valid ? __expf((z - sp) + lb) : 0.f;
        carry += __shfl(incl, 0);
    }
    __syncthreads();
    float o = 0.f;
    const bf16* vb = SV + (size_t)b * SEQ * 1024 + h * 64 + lane;
    const int nkp = nchunk * 64;
    for (int k = 0; k < nkp; ++k) o += sW[w][k] * bf2f(vb[(size_t)k * 1024]);
    OB[m * 1024 + h * 64 + lane] = (bf16)f2bf(o);
}


__device__ __forceinline__ void da_row_naive(LAS float* sS  , LAS float* sQ  , int b, int h, int q, int lane, float lam, const bf16* __restrict__ DQ, const bf16* __restrict__ DK, const bf16* __restrict__ DV,
                                             const float* __restrict__ rel_bias, const float* subln, bf16* OA) {
    const size_t m = (size_t)b * SEQ + q;
    sQ[lane] = bf2f(DQ[m * 1024 + h * 128 + lane]); sQ[lane + 64] = bf2f(DQ[m * 1024 + h * 128 + 64 + lane]);
    LDS_WAIT(); asm volatile("" ::: "memory");
    const int nk = (q / 64 + 1) * 64;
    float mx0 = -INFINITY, mx1 = -INFINITY;
    for (int k = lane; k < nk; k += 64) {
        const bf16* kr = DK + ((size_t)b * SEQ + k) * 1024 + h * 128;
        float s0 = 0.f, s1 = 0.f;
#pragma unroll
        for (int c = 0; c < 8; ++c) {
            const uint4 v0 = *(const uint4*)(kr + c * 8), v1 = *(const uint4*)(kr + 64 + c * 8);
            const unsigned a0[4] = {v0.x, v0.y, v0.z, v0.w}, a1[4] = {v1.x, v1.y, v1.z, v1.w};
#pragma unroll
            for (int e = 0; e < 4; ++e) {
                s0 += sQ[c * 8 + 2 * e] * __uint_as_float(a0[e] << 16) + sQ[c * 8 + 2 * e + 1] * __uint_as_float(a0[e] & 0xffff0000u);
                s1 += sQ[64 + c * 8 + 2 * e] * __uint_as_float(a1[e] << 16) + sQ[64 + c * 8 + 2 * e + 1] * __uint_as_float(a1[e] & 0xffff0000u);
            }
        }
        const int bk = rel_bucket(k - q);
        s0 = s0 + 1.4426950408889634f * rel_bias[bk * 16 + h * 2 + 0]; s1 = s1 + 1.4426950408889634f * rel_bias[bk * 16 + h * 2 + 1];
        sS[k] = s0; sS[SEQ + k] = s1; mx0 = fmaxf(mx0, s0); mx1 = fmaxf(mx1, s1);
    }
    mx0 = wave_max(mx0); mx1 = wave_max(mx1);
    float l0 = 0.f, l1 = 0.f;
    for (int k = lane; k < nk; k += 64) { const float p0 = exp2f(sS[k] - mx0), p1 = exp2f(sS[SEQ + k] - mx1); sS[k] = p0; sS[SEQ + k] = p1; l0 += p0; l1 += p1; }
    l0 = wave_sum(l0); l1 = wave_sum(l1);
    const float i0 = 1.0f / l0, i1 = lam / l1;
    for (int k = lane; k < nk; k += 64) sS[k] = sS[k] * i0 - sS[SEQ + k] * i1;
    LDS_WAIT(); asm volatile("" ::: "memory");
    float o0 = 0.f, o1 = 0.f;
    const bf16* vb = DV + (size_t)b * SEQ * 1024 + h * 128 + 2 * lane;
    for (int k = 0; k < nk; ++k) { const float a = sS[k]; const unsigned vv = *(const unsigned*)(vb + (size_t)k * 1024); o0 += a * __uint_as_float(vv << 16); o1 += a * __uint_as_float(vv & 0xffff0000u); }
    const float ss = wave_sum(o0 * o0 + o1 * o1);
    const float r = rsqrtf(ss * (1.0f / 128.0f) + SUBLN_EPS) * (1.0f - LAMBDA_INIT);
    *(unsigned*)(OA + m * 1024 + h * 128 + 2 * lane) = pk2(o0 * r * subln[2 * lane], o1 * r * subln[2 * lane + 1]);
    LDS_WAIT(); asm volatile("" ::: "memory");
}
__device__ __forceinline__ void sb_row_naive(LAS float* sW  , LAS float* sQ  , int b, int h, int q, int lane, const bf16* __restrict__ SQ, const bf16* __restrict__ SK, const bf16* __restrict__ SV, bf16* OB) {
    const size_t m = (size_t)b * SEQ + q;
    sQ[lane] = bf2f(SQ[m * 1024 + h * 64 + lane]);
    LDS_WAIT(); asm volatile("" ::: "memory");
    const int nchunk = (q + 63) / 64;
    float carry = 0.f;
    for (int c = nchunk - 1; c >= 0; --c) {
        const int j = c * 64 + lane; const bool valid = j < q;
        const bf16* kr = SK + ((size_t)b * SEQ + j) * 1024 + h * 64;
        float z = 0.f;
#pragma unroll
        for (int cc = 0; cc < 8; ++cc) {
            const uint4 v0 = *(const uint4*)(kr + cc * 8); const unsigned a0[4] = {v0.x, v0.y, v0.z, v0.w};
#pragma unroll
            for (int e = 0; e < 4; ++e) z += sQ[cc * 8 + 2 * e] * __uint_as_float(a0[e] << 16) + sQ[cc * 8 + 2 * e + 1] * __uint_as_float(a0[e] & 0xffff0000u);
        }
        z *= 0.6931471805599453f;
        const float sp = fmaxf(z, 0.f) + log1pf(__expf(-fabsf(z)));
        const float lk = valid ? -sp : 0.f;
        float incl = lk;
#pragma unroll
        for (int off = 1; off < 64; off <<= 1) { const float t = __shfl_down(incl, off); incl += (lane + off < 64) ? t : 0.f; }
        const float lb = carry + incl - lk;
        sW[j] = valid ? __expf((z - sp) + lb) : 0.f;
        carry += __shfl(incl, 0);
    }
    LDS_WAIT(); asm volatile("" ::: "memory");
    float o = 0.f;
    const bf16* vb = SV + (size_t)b * SEQ * 1024 + h * 64 + lane;
    const int nkp = nchunk * 64;
    for (int k = 0; k < nkp; ++k) o += sW[k] * bf2f(vb[(size_t)k * 1024]);
    OB[m * 1024 + h * 64 + lane] = (bf16)f2bf(o);
    LDS_WAIT(); asm volatile("" ::: "memory");
}

namespace att {
typedef __attribute__((ext_vector_type(8))) short bf16x8;
typedef __attribute__((ext_vector_type(4))) short s16x4;
typedef __attribute__((ext_vector_type(16))) float f32x16;
typedef __attribute__((ext_vector_type(4))) unsigned u32x4;
typedef __attribute__((address_space(3))) const char* lds_cptr;
#define ATT_LAS __attribute__((address_space(3)))
#define SBAR() __builtin_amdgcn_sched_barrier(0)
#define WAIT_BAR0() asm volatile("s_waitcnt vmcnt(0) lgkmcnt(0)\n\ts_barrier" ::: "memory")
#define LDS_BAR() asm volatile("s_waitcnt lgkmcnt(0)\n\ts_barrier" ::: "memory")
__device__ __forceinline__ int crowc(int r) { return (r & 3) + 8 * (r >> 2); }
__device__ __forceinline__ void glds16(const void* gsrc, unsigned lds_dst) { unsigned keep;
    asm volatile("s_mov_b32 %0, m0\n\ts_mov_b32 m0, %2\n\ts_nop 0\n\tglobal_load_lds_dwordx4 %1, off\n\ts_mov_b32 m0, %0" : "=&s"(keep) : "v"(gsrc), "s"(lds_dst) : "memory"); }
typedef float f32x2_t __attribute__((ext_vector_type(2))); typedef __bf16 bf16x2_t __attribute__((ext_vector_type(2)));
__device__ __forceinline__ unsigned cvtpk_s(float lo, float hi) { f32x2_t v = {lo, hi}; bf16x2_t b = __builtin_convertvector(v, bf16x2_t); return __builtin_bit_cast(unsigned, b); }
__device__ __forceinline__ void qkt(f32x16& p0, f32x16& p1, lds_cptr Kslot, const bf16x8* qr, const f32x16& cinit, int r32, int hi) {
    lds_cptr kb = Kslot + hi * 1024 + r32 * 16;
#pragma unroll
    for (int d0 = 0; d0 < 4; ++d0) {
        const bf16x8 b0 = *(const ATT_LAS bf16x8*)(kb + d0 * 2048);
        const bf16x8 b1 = *(const ATT_LAS bf16x8*)(kb + d0 * 2048 + 512);
        if (d0 == 0) { p0 = __builtin_amdgcn_mfma_f32_32x32x16_bf16(b0, qr[0], cinit, 0, 0, 0); p1 = __builtin_amdgcn_mfma_f32_32x32x16_bf16(b1, qr[0], cinit, 0, 0, 0); }
        else { p0 = __builtin_amdgcn_mfma_f32_32x32x16_bf16(b0, qr[d0], p0, 0, 0, 0); p1 = __builtin_amdgcn_mfma_f32_32x32x16_bf16(b1, qr[d0], p1, 0, 0, 0); } }
}
__device__ __forceinline__ void pv(f32x16* o, int vb, bf16x8 pa0, bf16x8 pa1, bf16x8 pa2, bf16x8 pa3) {
#pragma unroll
    for (int d0 = 0; d0 < 2; ++d0) { s16x4 lo[4], hi[4];
#pragma unroll
        for (int ks = 0; ks < 4; ++ks) {
            asm volatile("ds_read_b64_tr_b16 %0,%1 offset:%c2" : "=&v"(lo[ks]) : "v"(vb), "i"(d0 * 4096 + ks * 1024) : "memory");
            asm volatile("ds_read_b64_tr_b16 %0,%1 offset:%c2" : "=&v"(hi[ks]) : "v"(vb), "i"(d0 * 4096 + ks * 1024 + 512) : "memory"); }
        asm volatile("s_waitcnt lgkmcnt(0)" ::: "memory"); SBAR();
#define PK(k) (bf16x8){lo[k][0], lo[k][1], lo[k][2], lo[k][3], hi[k][0], hi[k][1], hi[k][2], hi[k][3]}
        o[d0] = __builtin_amdgcn_mfma_f32_32x32x16_bf16(pa0, PK(0), o[d0], 0, 0, 0);
        o[d0] = __builtin_amdgcn_mfma_f32_32x32x16_bf16(pa1, PK(1), o[d0], 0, 0, 0);
        o[d0] = __builtin_amdgcn_mfma_f32_32x32x16_bf16(pa2, PK(2), o[d0], 0, 0, 0);
        o[d0] = __builtin_amdgcn_mfma_f32_32x32x16_bf16(pa3, PK(3), o[d0], 0, 0, 0);
#undef PK
    }
}
#define PKW(P, B) cvtpk_s(P[B], P[(B) + 1])
#define PACK_P(P0, P1) do { pw0 = (u32x4){PKW(P0, 0), PKW(P0, 2), PKW(P0, 4), PKW(P0, 6)}; pw1 = (u32x4){PKW(P0, 8), PKW(P0, 10), PKW(P0, 12), PKW(P0, 14)}; \
                            pw2 = (u32x4){PKW(P1, 0), PKW(P1, 2), PKW(P1, 4), PKW(P1, 6)}; pw3 = (u32x4){PKW(P1, 8), PKW(P1, 10), PKW(P1, 12), PKW(P1, 14)}; } while (0)
#define PAF(k) __builtin_bit_cast(bf16x8, pw##k)

__device__ __forceinline__ void sb_unit(int b, int h, int qb, const bf16* SQ, const bf16* __restrict__ SK, const bf16* __restrict__ SV, bf16* OB, ATT_LAS unsigned char* Lb) {
    const int tid = threadIdx.x, lane = tid & 63, r32 = lane & 31, hi = lane >> 5; const int wid = __builtin_amdgcn_readfirstlane(tid >> 6);
    const long rowbase = (long)b * SEQ; const int q0 = qb * 256;
    const bf16* Qw = SQ + (rowbase + q0 + wid * 32) * 1024 + h * 64;
    const bf16* Kh = SK + rowbase * 1024 + h * 64; const bf16* Vh = SV + rowbase * 1024 + h * 64;
    const unsigned lds0 = (unsigned)(uintptr_t)Lb;
    const bf16* ksrc = Kh + (long)lane * 1024 + wid * 8;
    const bf16* vsrc = Vh + (long)(16 * (wid & 3) + (lane >> 2)) * 1024 + (wid >> 2) * 32 + (lane & 3) * 8;
    const unsigned kdst = lds0 + wid * 1024, vdst = lds0 + 8192 + wid * 1024;
#define DMA_K(t, slot) glds16(ksrc + (long)(t) * 64 * 1024, (unsigned)__builtin_amdgcn_readfirstlane(kdst + (slot)))
#define DMA_V(t, slot) glds16(vsrc + (long)(t) * 64 * 1024, (unsigned)__builtin_amdgcn_readfirstlane(vdst + (slot)))
    const int vb0 = (int)(lds0 + 8192) + ((lane >> 4) & 1) * 32 + (lane & 3) * 8 + (4 * hi + ((lane & 15) >> 2)) * 64;
    const int NT = 4 * (qb + 1);
    DMA_K(NT - 1, 0); DMA_V(NT - 1, 0);
    bf16x8 qr[4];
#pragma unroll
    for (int d0 = 0; d0 < 4; ++d0) qr[d0] = *reinterpret_cast<const bf16x8*>(&Qw[(long)r32 * 1024 + d0 * 16 + hi * 8]);
    f32x16 o[2]; o[0] = f32x16{}; o[1] = f32x16{};
    const f32x16 zero = f32x16{};
    float R = 0.f;
    const int qrel = wid * 32 + r32;
    for (int n = 0; n < NT; ++n) {
        const int t = NT - 1 - n; const int slot = (n & 1) * 16384;
        WAIT_BAR0();
        if (n + 1 < NT) { DMA_K(t - 1, slot ^ 16384); DMA_V(t - 1, slot ^ 16384); }
        const int jb = t - 4 * qb;
        const bool skip = (jb >= 0) && (64 * jb > 32 * wid + 30);
        if (!skip) {
            const bool partial = (jb >= 0) && !(64 * jb + 63 < 32 * wid);
            f32x16 p0, p1;
            qkt(p0, p1, (lds_cptr)(Lb + slot), qr, zero, r32, hi);
            const int kb = 64 * jb + 4 * hi;
            float lk0[16], lk1[16];
#pragma unroll
            for (int r = 0; r < 16; ++r) {
                { const float y = p0[r]; const float sp = fmaxf(y, 0.f) + __builtin_amdgcn_logf(1.0f + __builtin_amdgcn_exp2f(-fabsf(y)));
                  const bool v = !partial || (kb + crowc(r) < qrel); lk0[r] = v ? -sp : 0.f; p0[r] = v ? (y - sp) : -INFINITY; }
                { const float y = p1[r]; const float sp = fmaxf(y, 0.f) + __builtin_amdgcn_logf(1.0f + __builtin_amdgcn_exp2f(-fabsf(y)));
                  const bool v = !partial || (kb + 32 + crowc(r) < qrel); lk1[r] = v ? -sp : 0.f; p1[r] = v ? (y - sp) : -INFINITY; }
            }
            float G[8], PG[8], S8[8];
#pragma unroll
            for (int gi = 0; gi < 4; ++gi) { G[gi] = (lk0[4 * gi] + lk0[4 * gi + 1]) + (lk0[4 * gi + 2] + lk0[4 * gi + 3]); G[4 + gi] = (lk1[4 * gi] + lk1[4 * gi + 1]) + (lk1[4 * gi + 2] + lk1[4 * gi + 3]); }
#pragma unroll
            for (int gi = 0; gi < 8; ++gi) PG[gi] = __shfl_xor(G[gi], 32);
            S8[7] = 0.f;
#pragma unroll
            for (int gi = 6; gi >= 0; --gi) S8[gi] = S8[gi + 1] + (G[gi + 1] + PG[gi + 1]);
            const float total = S8[0] + (G[0] + PG[0]);
#pragma unroll
            for (int gi = 0; gi < 8; ++gi) {
                const float s3 = R + S8[gi] + (hi ? 0.f : PG[gi]);
                if (gi < 4) { const float s2 = s3 + lk0[4 * gi + 3], s1 = s2 + lk0[4 * gi + 2], s0 = s1 + lk0[4 * gi + 1];
                    p0[4 * gi + 3] = __builtin_amdgcn_exp2f(p0[4 * gi + 3] + s3); p0[4 * gi + 2] = __builtin_amdgcn_exp2f(p0[4 * gi + 2] + s2);
                    p0[4 * gi + 1] = __builtin_amdgcn_exp2f(p0[4 * gi + 1] + s1); p0[4 * gi] = __builtin_amdgcn_exp2f(p0[4 * gi] + s0); }
                else { const int g4 = gi - 4; const float s2 = s3 + lk1[4 * g4 + 3], s1 = s2 + lk1[4 * g4 + 2], s0 = s1 + lk1[4 * g4 + 1];
                    p1[4 * g4 + 3] = __builtin_amdgcn_exp2f(p1[4 * g4 + 3] + s3); p1[4 * g4 + 2] = __builtin_amdgcn_exp2f(p1[4 * g4 + 2] + s2);
                    p1[4 * g4 + 1] = __builtin_amdgcn_exp2f(p1[4 * g4 + 1] + s1); p1[4 * g4] = __builtin_amdgcn_exp2f(p1[4 * g4] + s0); }
            }
            R += total;
            u32x4 pw0, pw1, pw2, pw3; PACK_P(p0, p1);
            SBAR(); pv(o, vb0 + slot, PAF(0), PAF(1), PAF(2), PAF(3));
        }
    }
    bf16* Ow = OB + (rowbase + q0 + wid * 32) * 1024 + h * 64;
    {   ATT_LAS bf16* stg = (ATT_LAS bf16*)(Lb + 65536) + wid * 2048;
#pragma unroll
        for (int r = 0; r < 16; ++r) { const int orow = crowc(r) + 4 * hi;
#pragma unroll
            for (int d0 = 0; d0 < 2; ++d0) stg[orow * 64 + d0 * 32 + r32] = (bf16)f2bf(o[d0][r]); }
        asm volatile("s_waitcnt lgkmcnt(0)" ::: "memory");
#pragma unroll
        for (int i = 0; i < 4; ++i) { const int row = i * 8 + (lane >> 3), ch = lane & 7; const u32x4 v = *(const ATT_LAS u32x4*)(stg + row * 64 + ch * 8); *(u32x4*)(Ow + (long)row * 1024 + ch * 8) = v; } }
    LDS_BAR();
#undef DMA_K
#undef DMA_V
}

__device__ __forceinline__ void da_unit(int b, int h, int iu, const bf16* DQ, const bf16* __restrict__ DK, const bf16* __restrict__ DV, bf16* OA, ATT_LAS unsigned char* Lb, ATT_LAS float* TB, ATT_LAS float* wsf_all,
                                        const float* __restrict__ rel_bias, const float* __restrict__ subln, float lam) {
    const int tid = threadIdx.x, lane = tid & 63, r32 = lane & 31, hi = lane >> 5; const int wid = __builtin_amdgcn_readfirstlane(tid >> 6);
    const int qblk = wid & 3, mp = wid >> 2;
    const long rowbase = (long)b * SEQ; const int q0 = iu * 128;
    const int c = 2 * iu + (qblk >> 1);
    const int qc = 32 * (qblk & 1) + r32;
    ATT_LAS float* wsf = wsf_all + wid * 64;
    {   const int mm = tid >> 8, i = tid & 255; const int rel = i - 191;
        TB[mm * 256 + i] = (i < 255) ? rel_bias[rel_bucket(rel) * 16 + 2 * h + mm] * 1.4426950408889634f : 0.f; }
    const float bfar = rel_bias[15 * 16 + 2 * h + mp] * 1.4426950408889634f;
    const bf16* Qw = DQ + (rowbase + q0 + 32 * qblk) * 1024 + h * 128 + mp * 64;
    const unsigned lds0 = (unsigned)(uintptr_t)Lb;
    const bf16* ksrc = DK + (rowbase + lane) * 1024 + h * 128 + wid * 8;
    const bf16* vsrc = DV + (rowbase + 16 * (wid & 3) + (lane >> 2)) * 1024 + h * 128 + (wid >> 2) * 32 + (lane & 3) * 8;
    const unsigned pdst = lds0 + wid * 1024;
#define DMA_TILE(t, slot) do { const unsigned d_ = (unsigned)__builtin_amdgcn_readfirstlane(pdst + (slot)); const long to_ = (long)(t) * 64 * 1024; \
        glds16(ksrc + to_, d_); glds16(ksrc + to_ + 64, d_ + 8192); glds16(vsrc + to_, d_ + 16384); glds16(vsrc + to_ + 64, d_ + 24576); } while (0)
    const int vb0 = (int)(lds0 + 16384) + ((lane >> 4) & 1) * 32 + (lane & 3) * 8 + (4 * hi + ((lane & 15) >> 2)) * 64;
    const int NT = 2 * iu + 2;
    DMA_TILE(0, 0);
    bf16x8 qr[4];
#pragma unroll
    for (int d0 = 0; d0 < 4; ++d0) qr[d0] = *reinterpret_cast<const bf16x8*>(&Qw[(long)r32 * 1024 + d0 * 16 + hi * 8]);
    f32x16 o[4]; o[0] = f32x16{}; o[1] = f32x16{}; o[2] = f32x16{}; o[3] = f32x16{};
    float mrun = -1e30f, lsum = 0.f;
    for (int n = 0; n < NT; ++n) {
        const int t = n; const int slot = (n & 1) * 32768;
        WAIT_BAR0();
        if (n + 1 < NT) DMA_TILE(t + 1, slot ^ 32768);
        if (t <= c) {
            const bool near = (t >= c - 2);
            const float ci = near ? 0.f : bfar;
            f32x16 cinit;
#pragma unroll
            for (int r = 0; r < 16; ++r) cinit[r] = ci;
            f32x16 p0, p1;
            qkt(p0, p1, (lds_cptr)(Lb + slot + mp * 8192), qr, cinit, r32, hi);
            if (near) {
                const ATT_LAS float* tbp = TB + mp * 256 + (64 * (t - c + 2) + 63 - qc + 4 * hi);
#pragma unroll
                for (int r = 0; r < 16; ++r) { p0[r] += tbp[crowc(r)]; p1[r] += tbp[32 + crowc(r)]; }
            }
            float rm = fmaxf(p0[0], p1[0]);
#pragma unroll
            for (int r = 1; r < 16; ++r) rm = fmaxf(rm, fmaxf(p0[r], p1[r]));
            rm = fmaxf(rm, __shfl_xor(rm, 32));
            const float mnew = fmaxf(mrun, rm); const float f = __builtin_amdgcn_exp2f(mrun - mnew); mrun = mnew;
            if (hi == 0) wsf[r32] = f;
            float ps = 0.f;
#pragma unroll
            for (int r = 0; r < 16; ++r) { p0[r] = __builtin_amdgcn_exp2f(p0[r] - mnew); p1[r] = __builtin_amdgcn_exp2f(p1[r] - mnew); ps += p0[r] + p1[r]; }
            lsum = lsum * f + ps;
            asm volatile("s_waitcnt lgkmcnt(0)" ::: "memory");
#pragma unroll
            for (int r = 0; r < 16; ++r) { const float fr_ = wsf[crowc(r) + 4 * hi];
#pragma unroll
                for (int d = 0; d < 4; ++d) o[d][r] *= fr_; }
            u32x4 pw0, pw1, pw2, pw3; PACK_P(p0, p1);
            SBAR(); pv(o, vb0 + slot, PAF(0), PAF(1), PAF(2), PAF(3));
            SBAR(); pv(o + 2, vb0 + slot + 8192, PAF(0), PAF(1), PAF(2), PAF(3));
        }
    }
    {   const float lt = lsum + __shfl_xor(lsum, 32); float inv = 1.0f / lt; if (mp == 1) inv *= lam;
        asm volatile("s_waitcnt lgkmcnt(0)" ::: "memory");
        if (hi == 0) wsf[r32] = inv;
        asm volatile("s_waitcnt lgkmcnt(0)" ::: "memory");
#pragma unroll
        for (int r = 0; r < 16; ++r) { const float fr_ = wsf[crowc(r) + 4 * hi];
#pragma unroll
            for (int d = 0; d < 4; ++d) o[d][r] *= fr_; } }
    LDS_BAR();
    ATT_LAS float* X = (ATT_LAS float*)Lb + (size_t)qblk * (4 * 16 * 64) + lane;
    if (mp == 1) {
#pragma unroll
        for (int d = 0; d < 4; ++d)
#pragma unroll
            for (int r = 0; r < 16; ++r) X[(d * 16 + r) * 64] = o[d][r];
    }
    LDS_BAR();
    if (mp == 0) {
        float ssq[16];
#pragma unroll
        for (int r = 0; r < 16; ++r) { float s = 0.f;
#pragma unroll
            for (int d = 0; d < 4; ++d) { o[d][r] -= X[(d * 16 + r) * 64]; s += o[d][r] * o[d][r]; }
            ssq[r] = s; }
#pragma unroll
        for (int r = 0; r < 16; ++r) {
#pragma unroll
            for (int off = 1; off < 32; off <<= 1) ssq[r] += __shfl_xor(ssq[r], off);
            ssq[r] = rsqrtf(ssq[r] * (1.0f / 128.0f) + SUBLN_EPS) * (1.0f - LAMBDA_INIT); }
        bf16* Ow = OA + (rowbase + q0 + 32 * qblk) * 1024 + h * 128 + r32;
#pragma unroll
        for (int d = 0; d < 4; ++d) { const float gsub = subln[32 * d + r32];
#pragma unroll
            for (int r = 0; r < 16; ++r) Ow[(long)(crowc(r) + 4 * hi) * 1024 + 32 * d] = (bf16)f2bf(o[d][r] * ssq[r] * gsub); }
    }
    LDS_BAR();
#undef DMA_TILE
}
#undef PKW
#undef PACK_P
#undef PAF
#undef SBAR
#undef WAIT_BAR0
#undef LDS_BAR
}

struct Args { const float* in[19]; float* out; unsigned char* ws; int ph_lo, ph_hi, li, pad; };
constexpr int N_PHASES = 10;
__global__ void __launch_bounds__(NWAVES * 64, 2) mega_fwd(Args args) {
    extern __shared__ __attribute__((aligned(16))) unsigned char lds[];
    LAS unsigned char* const L = (LAS unsigned char*)lds;
    volatile LAS unsigned* const MISC = (volatile LAS unsigned*)(L + MISC_OFF);
    const int tid = threadIdx.x, lane = tid & 63, wave = __builtin_amdgcn_readfirstlane(tid >> 6);
    const int G = gridDim.x; const int bx = blockIdx.x; const int vcu = (G % 8 == 0) ? (bx % 8) * (G / 8) + bx / 8 : bx;
    unsigned char* const ws = args.ws;
    gu32* const ctl = (gu32*)(ws + WS_CTL);
    const float* const x = args.in[0];
    float* const out = args.out;
    bf16* const XB = (bf16*)(ws + WS_XB); bf16* const HB = (bf16*)(ws + WS_H);
    float* const RS1 = (float*)(ws + WS_CTL) + CW_RS1; float* const SS2 = (float*)(ws + WS_CTL) + CW_SS2; float* const SS3 = (float*)(ws + WS_CTL) + CW_SS3; float* const SS4 = (float*)(ws + WS_CTL) + CW_SS4;
    for (int u = tid; u < (LDS_BYTES - LDSCTL_OFF) / 4; u += NWAVES * 64) ((LAS unsigned*)(L + LDSCTL_OFF))[u] = 0u;
    __syncthreads();
    const int lo = args.ph_lo, hi = args.ph_hi;
    const bool use_bar = (hi - lo) > 1;
    XcdBarrier bar; bar.bar = (unsigned*)(ctl + CW_BAR) + args.li * XCD_BAR_WORDS; bar.x = 0; bar.st = nullptr;
    if (use_bar) bar = xcd_barrier_post((unsigned*)(ctl + CW_BAR) + args.li * XCD_BAR_WORDS, MISC + 8);
#define IN(k) (lo <= (k) && (k) < hi)
#define SEAM(k) do { if (IN(k) && IN((k) + 1)) xcd_barrier(bar); } while (0)
    const int gw = vcu * NWAVES + wave, NGW = G * NWAVES;

    if (IN(0)) {
        constexpr int I_GU = (D / 64) * (2 * FF / 64), I_DN = (FF / 64) * (D / 64), I_IN = (D / 64) * (NIN / 64), I_BR = (1024 / 64) * (D / 64), I_OUT = (D / 64) * (D / 64);
        constexpr int NITEMS = 2 * I_GU + 2 * I_DN + I_IN + 2 * I_BR + I_OUT;
        for (int it = gw; it < NITEMS; it += NGW) {
            int r = it;
            if (r < I_GU) { p0_convert_item<true>(args.in[3], D, 2 * FF, args.in[2], (bf16*)(ws + WS_WGU1), r, lane); continue; } r -= I_GU;
            if (r < I_GU) { p0_convert_item<true>(args.in[16], D, 2 * FF, args.in[15], (bf16*)(ws + WS_WGU2), r, lane); continue; } r -= I_GU;
            if (r < I_DN) { p0_convert_item<false>(args.in[4], FF, D, nullptr, (bf16*)(ws + WS_WD1), r, lane); continue; } r -= I_DN;
            if (r < I_DN) { p0_convert_item<false>(args.in[17], FF, D, nullptr, (bf16*)(ws + WS_WD2), r, lane); continue; } r -= I_DN;
            if (r < I_IN) { p0_convert_item<false>(args.in[6], D, NIN, args.in[5], (bf16*)(ws + WS_WIN), r, lane); continue; } r -= I_IN;
            if (r < I_BR) { p0_convert_item<false>(args.in[12], 1024, D, nullptr, (bf16*)(ws + WS_WA), r, lane); continue; } r -= I_BR;
            if (r < I_BR) { p0_convert_item<false>(args.in[13], 1024, D, nullptr, (bf16*)(ws + WS_WB), r, lane); continue; } r -= I_BR;
            p0_convert_item<false>(args.in[14], D, D, nullptr, (bf16*)(ws + WS_WOUT), r, lane);
        }
        for (int m = gw; m < M; m += NGW) {
            const GAS f32x4* xr = (const GAS f32x4*)(x + (size_t)m * D) + lane;
            f32x4 v[8]; float s = 0.f;
#pragma unroll
            for (int j = 0; j < 8; ++j) { v[j] = xr[64 * j]; s += (v[j].x * v[j].x + v[j].y * v[j].y) + (v[j].z * v[j].z + v[j].w * v[j].w); }
            s = wave_sum(s);
            if (lane == 0) RS1[m] = rsqrtf(s * (1.0f / D) + 1e-6f);
            GAS unsigned long long* o8 = (GAS unsigned long long*)(XB + (size_t)m * D) + lane;
#pragma unroll
            for (int j = 0; j < 8; ++j) o8[64 * j] = (unsigned long long)cvtpk(v[j].x, v[j].y) | ((unsigned long long)cvtpk(v[j].z, v[j].w) << 32);
        }
    }
    SEAM(0);
    if (IN(1)) {
        pg8::Gemm g{XB, (const bf16*)(ws + WS_WGU1), M, 2 * FF, D}; pg8::StaticOrder S; S.init(M, 2 * FF, G, bx);
        pg8::EpiSwiGLU<false> E{HB, RS1};
        pg8::gemm_phase<pg8::EpiSwiGLU<false>, pg8::StaticOrder, PG8_ALIGN, PG8_SP2>(L + RING_OFF, g, S, E);
    }
    SEAM(1);
    if (IN(2)) {
        pg8::Gemm g{HB, (const bf16*)(ws + WS_WD1), M, D, FF}; pg8::StaticOrder S; S.init(M, D, G, bx);
        pg8::EpiResid<true> E{x, out, XB, SS2, 0.5f};
        pg8::gemm_phase<pg8::EpiResid<true>, pg8::StaticOrder, PG8_ALIGN, PG8_SP2>(L + RING_OFF, g, S, E);
    }
    SEAM(2);
    if (IN(3)) {
        pg8::Gemm g{XB, (const bf16*)(ws + WS_WIN), M, 6144, D}; pg8::StaticOrder S; S.init(M, 6144, G, bx);
        pg8::EpiQKV E{(bf16*)(ws + WS_QKV), QKV_SPLIT / 2, SS2, C2};
        pg8::gemm_phase<pg8::EpiQKV, pg8::StaticOrder, PG8_ALIGN, PG8_SP2>(L + RING_OFF, g, S, E);
    }
    SEAM(3);
    if (IN(4)) {
        const bf16* q6 = (const bf16*)(ws + WS_QKV); const size_t sp = QKV_SPLIT / 2;
#ifndef ATT_NAIVE_DA
        {   const float lam = __expf(wave_sum(args.in[7][lane] * args.in[8][lane])) - __expf(wave_sum(args.in[9][lane] * args.in[10][lane])) + LAMBDA_INIT;
            LAS float* TB = (LAS float*)(L + LDSCTL_OFF + 1024); LAS float* wsf = (LAS float*)(L + LDSCTL_OFF + 4096);
            const int bh = vcu >> 3, s8 = vcu & 7;
            for (int i = 0; i < 2; ++i)
                att::da_unit(bh / DA_HEADS, bh % DA_HEADS, i == 0 ? 15 - s8 : s8, q6, q6 + sp, q6 + 2 * sp, (bf16*)(ws + WS_OA), L + RING_OFF, TB, wsf, args.in[1], args.in[11], lam);
        }
#endif
#ifndef ATT_NAIVE_SB
        {   const int bh = vcu >> 2, s4 = vcu & 3;
            for (int i = 0; i < 2; ++i)
                att::sb_unit(bh / SB_HEADS, bh % SB_HEADS, i == 0 ? 7 - s4 : s4, q6 + 3 * sp, q6 + 4 * sp, q6 + 5 * sp, (bf16*)(ws + WS_OB), L + RING_OFF);
        }
#endif
#if defined(ATT_NAIVE_DA) || defined(ATT_NAIVE_SB)
        {   LAS float* sS = (LAS float*)(L + RING_OFF) + wave * (2 * SEQ); LAS float* sQ = (LAS float*)(L + LDSCTL_OFF + 1024) + wave * 128;
            __syncthreads();
#ifdef ATT_NAIVE_DA
            const float lam = __expf(wave_sum(args.in[7][lane] * args.in[8][lane])) - __expf(wave_sum(args.in[9][lane] * args.in[10][lane])) + LAMBDA_INIT;
            for (int i = 0; i < BATCH * DA_HEADS; ++i) { const int q = (gw + 65 * i) & (SEQ - 1);
                da_row_naive(sS, sQ, i / DA_HEADS, i % DA_HEADS, q, lane, lam, q6, q6 + sp, q6 + 2 * sp, args.in[1], args.in[11], (bf16*)(ws + WS_OA)); }
#endif
#ifdef ATT_NAIVE_SB
            for (int i = 0; i < BATCH * SB_HEADS; ++i) { const int q = (gw + 65 * i) & (SEQ - 1);
                sb_row_naive(sS, sQ, i / SB_HEADS, i % SB_HEADS, q, lane, q6 + 3 * sp, q6 + 4 * sp, q6 + 5 * sp, (bf16*)(ws + WS_OB)); }
#endif
            __syncthreads();
        }
#endif
    }
    SEAM(4);
    if (IN(5)) {
        bf16* const Gt = (bf16*)(ws + WS_G); float* const T = (float*)(ws + WS_T); bf16* const MG = (bf16*)(ws + WS_MG);
        pg8::StaticOrder S; S.init(M, D, G, bx);
        { pg8::Gemm g{XB, (const bf16*)(ws + WS_WIN) + (size_t)6144 * D, M, D, D}; pg8::EpiGate E{Gt, SS2};
          pg8::gemm_phase<pg8::EpiGate, pg8::StaticOrder, PG8_ALIGN, PG8_SP2>(L + RING_OFF, g, S, E); }
        { pg8::Gemm g{(const bf16*)(ws + WS_OA), (const bf16*)(ws + WS_WA), M, D, 1024}; pg8::EpiBranch<true> E{Gt, T, MG};
          pg8::gemm_phase<pg8::EpiBranch<true>, pg8::StaticOrder, PG8_ALIGN, PG8_SP2>(L + RING_OFF, g, S, E); }
        { pg8::Gemm g{XB, (const bf16*)(ws + WS_WIN) + (size_t)8192 * D, M, D, D}; pg8::EpiGate E{Gt, SS2};
          pg8::gemm_phase<pg8::EpiGate, pg8::StaticOrder, PG8_ALIGN, PG8_SP2>(L + RING_OFF, g, S, E); }
        { pg8::Gemm g{(const bf16*)(ws + WS_OB), (const bf16*)(ws + WS_WB), M, D, 1024}; pg8::EpiBranch<false> E{Gt, T, MG};
          pg8::gemm_phase<pg8::EpiBranch<false>, pg8::StaticOrder, PG8_ALIGN, PG8_SP2>(L + RING_OFF, g, S, E); }
    }
    SEAM(5);
    if (IN(6)) {
        pg8::Gemm g{(const bf16*)(ws + WS_MG), (const bf16*)(ws + WS_WOUT), M, D, D}; pg8::StaticOrder S; S.init(M, D, G, bx);
        pg8::EpiResid<true> E{out, out, XB, SS3, 1.0f};
        pg8::gemm_phase<pg8::EpiResid<true>, pg8::StaticOrder, PG8_ALIGN, PG8_SP2>(L + RING_OFF, g, S, E);
    }
    SEAM(6);
    if (IN(7)) {
        pg8::Gemm g{XB, (const bf16*)(ws + WS_WGU2), M, 2 * FF, D}; pg8::StaticOrder S; S.init(M, 2 * FF, G, bx);
        pg8::EpiSwiGLU<true> E{HB, SS3};
        pg8::gemm_phase<pg8::EpiSwiGLU<true>, pg8::StaticOrder, PG8_ALIGN, PG8_SP2>(L + RING_OFF, g, S, E);
    }
    SEAM(7);
    if (IN(8)) {
        pg8::Gemm g{HB, (const bf16*)(ws + WS_WD2), M, D, FF}; pg8::StaticOrder S; S.init(M, D, G, bx);
        pg8::EpiResid<false> E{out, out, nullptr, SS4, 0.5f};
        pg8::gemm_phase<pg8::EpiResid<false>, pg8::StaticOrder, PG8_ALIGN, PG8_SP2>(L + RING_OFF, g, S, E);
    }
    SEAM(8);
    if (IN(9)) {
        const float* gf = args.in[18];
        for (int m = gw; m < M; m += NGW) {
            GAS f32x4* xr = (GAS f32x4*)(out + (size_t)m * D) + lane; const GAS f32x4* gr = (const GAS f32x4*)gf + lane;
            const float r = rsqrtf(SS4[m] * (1.0f / D) + 1e-6f);
#pragma unroll
            for (int j = 0; j < 8; ++j) { const f32x4 v = xr[64 * j]; xr[64 * j] = v * r * gr[64 * j]; }
        }
    }
#undef IN
#undef SEAM
}

extern "C" void kernel_launch(void* const* d_in, const int* in_sizes, int n_in, void* d_out, int out_size, void* d_ws, size_t ws_size, hipStream_t stream) {
    static int grid = 0;
    if (grid == 0) {
        if (n_in != 19 || out_size != M * D || ws_size < WS_END) { fprintf(stderr, "kernel_launch: unexpected shapes (n_in %d out %d ws %zu)\n", n_in, out_size, ws_size); grid = -1; return; }
        int dev = 0, cus = 0, per_cu = 0;
        if (hipGetDevice(&dev) != hipSuccess || hipDeviceGetAttribute(&cus, hipDeviceAttributeMultiprocessorCount, dev) != hipSuccess) { grid = -1; return; }
        if (hipFuncSetAttribute((const void*)mega_fwd, hipFuncAttributeMaxDynamicSharedMemorySize, LDS_BYTES) != hipSuccess) { fprintf(stderr, "kernel_launch: hipFuncSetAttribute failed\n"); grid = -1; return; }
        if (hipOccupancyMaxActiveBlocksPerMultiprocessor(&per_cu, (const void*)mega_fwd, NWAVES * 64, LDS_BYTES) != hipSuccess || per_cu < 1) fprintf(stderr, "kernel_launch: occupancy query says %d\n", per_cu);
        (void)hipGetLastError();
        grid = cus;
    }
    if (grid < 0) return;
    (void)hipMemsetAsync((char*)d_ws + WS_CTL, 0, CTL_ZERO_BYTES, stream);
    Args a{};
    for (int i = 0; i < 19; ++i) a.in[i] = (const float*)d_in[i];
    a.out = (float*)d_out; a.ws = (unsigned char*)d_ws;
    unsigned char* ws = (unsigned char*)d_ws;
    auto mega = [&](int lo, int hi, int li) { a.ph_lo = lo; a.ph_hi = hi; a.li = li; hipLaunchKernelGGL(mega_fwd, dim3(grid), dim3(NWAVES * 64), LDS_BYTES, stream, a); };
    auto naive_attn = [&]() {
        const bf16* q6 = (const bf16*)(ws + WS_QKV); const size_t sp = QKV_SPLIT / 2;
        k_da_naive<<<BATCH * DA_HEADS * SEQ / 2, 128, 0, stream>>>(q6, q6 + sp, q6 + 2 * sp, a.in[1], a.in[7], a.in[8], a.in[9], a.in[10], a.in[11], (bf16*)(ws + WS_OA));
        k_sb_naive<<<BATCH * SB_HEADS * SEQ / 4, 256, 0, stream>>>(q6 + 3 * sp, q6 + 4 * sp, q6 + 5 * sp, (bf16*)(ws + WS_OB));
    };
#if MK_MODE == 0
    for (int p = 0; p < N_PHASES; ++p) { if (p == 4) naive_attn(); else mega(p, p + 1, 0); }
#elif MK_MODE == 1
    mega(0, 4, 0); naive_attn(); mega(5, N_PHASES, 1);
#else
    mega(0, N_PHASES, 0);
#endif
}
```

```cpp
#include <hip/hip_runtime.h>
#include <cstdio>
#include <cstdint>
#include <math.h>

namespace pg8 {
#define PG8_LAS __attribute__((address_space(3)))
typedef unsigned short bf16_t;
typedef short bf16x8 __attribute__((ext_vector_type(8)));
typedef float f32x4 __attribute__((ext_vector_type(4)));
typedef unsigned u32x4 __attribute__((ext_vector_type(4)));
constexpr int BM = 256, BK = 64, HALF = 128, HTB = HALF * BK * 2  , STAGE_BYTES = 8 * HTB, NXCD = 8, WGM = 8;

__host__ __device__ __forceinline__ int lds_byte(int r, int c) { const int st = (r >> 4) * 2 + (c >> 5), rr = r & 15, cc = c & 31, ob = rr * 64 + cc * 2; return st * 1024 + (ob ^ (((ob >> 9) & 1) << 5)); }
__host__ __device__ __forceinline__ void stage_rc(int b, int& R, int& C) { const int st = b / 1024, sb = b % 1024, swz = sb ^ (((sb >> 9) & 1) << 5); R = (st >> 1) * 16 + swz / 64; C = (st & 1) * 32 + (swz % 64) / 2; }
__host__ __device__ __forceinline__ int perm32(int rho) { const int n = rho >> 4, i = rho & 15; return 8 * (i >> 2) + 4 * n + (i & 3); }

struct Unit { int pm, pn; };
struct Gemm { const bf16_t* A; const bf16_t* Bt; int M, N, K; };

struct StaticOrder {
    int nM, nN, nwg, G, c;
    __host__ __device__ void init(int M, int N, int G_, int c_) { nM = M / BM; nN = N / BM; nwg = nM * nN; G = G_; c = c_; }
    __host__ __device__ bool next(int i, Unit& u) const {
        const long L = (long)i * G + c; if (L >= nwg) return false;
        int wgid = (int)L; { const int q = nwg / NXCD, r = nwg % NXCD, xcd = wgid % NXCD, off = wgid / NXCD; wgid = (xcd < r ? xcd * (q + 1) : r * (q + 1) + (xcd - r) * q) + off; }
        const int nig = WGM * nN, gid = wgid / nig, fm = gid * WGM, gsz = (nM - fm) < WGM ? (nM - fm) : WGM;
        u.pm = fm + ((wgid % nig) % gsz); u.pn = (wgid % nig) / gsz; return true;
    }
    __device__ __forceinline__ void a_ready(const Unit&) const {}
    __device__ __forceinline__ void done(const Unit&) const {}
};
__device__ __forceinline__ unsigned cvt_pk_bf16(float lo, float hi) { unsigned r; asm volatile("v_cvt_pk_bf16_f32 %0, %1, %2" : "=v"(r) : "v"(lo), "v"(hi)); return r; }
typedef float f32x2 __attribute__((ext_vector_type(2)));
constexpr float RMS_EPS = 1e-6f, LOG2E = 1.4426950408889634f;
__device__ __forceinline__ float rstd_of(float ss) { return rsqrtf(ss * (1.0f / 2048.0f) + RMS_EPS); }
__device__ __forceinline__ float sigm(float g) { return __builtin_amdgcn_rcpf(1.0f + __builtin_amdgcn_exp2f(-LOG2E * g)); }
__device__ __forceinline__ u32x4 pack8(const f32x4& a, const f32x4& b) { u32x4 w; w.x = cvt_pk_bf16(a[0], a[1]); w.y = cvt_pk_bf16(a[2], a[3]); w.z = cvt_pk_bf16(b[0], b[1]); w.w = cvt_pk_bf16(b[2], b[3]); return w; }
__device__ __forceinline__ float bflo(unsigned w) { return __uint_as_float(w << 16); }
__device__ __forceinline__ float bfhi(unsigned w) { return __uint_as_float(w & 0xffff0000u); }
template <bool SSQ> struct EpiSwiGLU {
    static constexpr bool PERM = true, AFTER_DRAIN = false;
    bf16_t* H; const float* rs;
    __device__ __forceinline__ void operator()(const f32x4 (&acc)[2][2][4][2], const Unit& u, int wr, int wc, int fr, int fq) const {
        const int row0 = u.pm * BM + wr * 64 + fr, col0 = u.pn * 128 + wc * 32 + 8 * fq;
#pragma unroll
        for (int ai = 0; ai < 2; ++ai)
#pragma unroll
            for (int m = 0; m < 4; ++m) {
                const int row = row0 + ai * HALF + m * 16;
                float r = rs[row]; if (SSQ) r = rstd_of(r);
                f32x4 h0, h1;
#pragma unroll
                for (int e = 0; e < 4; ++e) {
                    const float g0 = acc[ai][0][m][0][e] * r, g1 = acc[ai][0][m][1][e] * r;
                    h0[e] = g0 * sigm(g0) * (acc[ai][1][m][0][e] * r); h1[e] = g1 * sigm(g1) * (acc[ai][1][m][1][e] * r);
                }
                *(u32x4*)(H + (size_t)row * 5632 + col0) = pack8(h0, h1);
            }
    }
};
template <bool WRITE_BF16> struct EpiResid {
    static constexpr bool PERM = true, AFTER_DRAIN = false;
    const float* xin; float* xout; bf16_t* xb; float* ss; float alpha;
    __device__ __forceinline__ void operator()(const f32x4 (&acc)[2][2][4][2], const Unit& u, int wr, int wc, int fr, int fq) const {
        const int row0 = u.pm * BM + wr * 64 + fr, col0 = u.pn * BM + wc * 32 + 8 * fq;
#pragma unroll
        for (int ai = 0; ai < 2; ++ai)
#pragma unroll
            for (int m = 0; m < 4; ++m) {
                const int row = row0 + ai * HALF + m * 16; const size_t off = (size_t)row * 2048 + col0; float sq = 0.f;
#pragma unroll
                for (int bj = 0; bj < 2; ++bj) {
                    const f32x4 a0 = *(const f32x4*)(xin + off + bj * HALF), a1 = *(const f32x4*)(xin + off + bj * HALF + 4);
                    const f32x4 o0 = a0 + acc[ai][bj][m][0] * alpha, o1 = a1 + acc[ai][bj][m][1] * alpha;
                    *(f32x4*)(xout + off + bj * HALF) = o0; *(f32x4*)(xout + off + bj * HALF + 4) = o1;
                    sq += (o0[0] * o0[0] + o0[1] * o0[1]) + (o0[2] * o0[2] + o0[3] * o0[3]) + (o1[0] * o1[0] + o1[1] * o1[1]) + (o1[2] * o1[2] + o1[3] * o1[3]);
                    if (WRITE_BF16) *(u32x4*)(xb + off + bj * HALF) = pack8(o0, o1);
                }
                sq += __shfl_xor(sq, 16); sq += __shfl_xor(sq, 32);
                if (fq == 0) atomicAdd(ss + row, sq);
                if (m & 1) asm volatile("" ::: "memory");
            }
    }
};
struct EpiQKV {
    static constexpr bool PERM = true, AFTER_DRAIN = false;
    bf16_t* base; size_t split; const float* ss; float qscale;
    __device__ __forceinline__ void operator()(const f32x4 (&acc)[2][2][4][2], const Unit& u, int wr, int wc, int fr, int fq) const {
        const int row0 = u.pm * BM + wr * 64 + fr; int colt = u.pn * BM; const int t = colt / 1024; colt -= t * 1024;
        bf16_t* ob = base + (size_t)t * split; const float sc = (t == 0 || t == 3) ? qscale : 1.0f; const int col0 = colt + wc * 32 + 8 * fq;
#pragma unroll
        for (int ai = 0; ai < 2; ++ai)
#pragma unroll
            for (int m = 0; m < 4; ++m) {
                const int row = row0 + ai * HALF + m * 16; const float r = rstd_of(ss[row]) * sc;
#pragma unroll
                for (int bj = 0; bj < 2; ++bj) *(u32x4*)(ob + (size_t)row * 1024 + col0 + bj * HALF) = pack8(acc[ai][bj][m][0] * r, acc[ai][bj][m][1] * r);
            }
    }
};
struct EpiGate {
    static constexpr bool PERM = true, AFTER_DRAIN = false;
    bf16_t* G; const float* ss;
    __device__ __forceinline__ void operator()(const f32x4 (&acc)[2][2][4][2], const Unit& u, int wr, int wc, int fr, int fq) const {
        const int row0 = u.pm * BM + wr * 64 + fr, col0 = u.pn * BM + wc * 32 + 8 * fq;
#pragma unroll
        for (int ai = 0; ai < 2; ++ai)
#pragma unroll
            for (int m = 0; m < 4; ++m) {
                const int row = row0 + ai * HALF + m * 16; const float r = rstd_of(ss[row]);
#pragma unroll
                for (int bj = 0; bj < 2; ++bj) { f32x4 s0, s1;
#pragma unroll
                    for (int e = 0; e < 4; ++e) { s0[e] = sigm(acc[ai][bj][m][0][e] * r); s1[e] = sigm(acc[ai][bj][m][1][e] * r); }
                    *(u32x4*)(G + (size_t)row * 2048 + col0 + bj * HALF) = pack8(s0, s1); }
            }
    }
};
template <bool FIRST> struct EpiBranch {
    static constexpr bool PERM = true, AFTER_DRAIN = false;
    const bf16_t* G; float* T; bf16_t* MG;
    __device__ __forceinline__ void operator()(const f32x4 (&acc)[2][2][4][2], const Unit& u, int wr, int wc, int fr, int fq) const {
        const int row0 = u.pm * BM + wr * 64 + fr, col0 = u.pn * BM + wc * 32 + 8 * fq;
#pragma unroll
        for (int ai = 0; ai < 2; ++ai)
#pragma unroll
            for (int m = 0; m < 4; ++m) {
                const int row = row0 + ai * HALF + m * 16;
#pragma unroll
                for (int bj = 0; bj < 2; ++bj) { const size_t off = (size_t)row * 2048 + col0 + bj * HALF;
                    const u32x4 g = *(const u32x4*)(G + off);
                    f32x4 o0, o1;
                    o0[0] = bflo(g.x) * acc[ai][bj][m][0][0]; o0[1] = bfhi(g.x) * acc[ai][bj][m][0][1]; o0[2] = bflo(g.y) * acc[ai][bj][m][0][2]; o0[3] = bfhi(g.y) * acc[ai][bj][m][0][3];
                    o1[0] = bflo(g.z) * acc[ai][bj][m][1][0]; o1[1] = bfhi(g.z) * acc[ai][bj][m][1][1]; o1[2] = bflo(g.w) * acc[ai][bj][m][1][2]; o1[3] = bfhi(g.w) * acc[ai][bj][m][1][3];
                    if (FIRST) { *(f32x4*)(T + off) = o0; *(f32x4*)(T + off + 4) = o1; }
                    else { o0 += *(const f32x4*)(T + off); o1 += *(const f32x4*)(T + off + 4); *(u32x4*)(MG + off) = pack8(o0, o1); } }
                if (m & 1) asm volatile("" ::: "memory");
            }
    }
};


template <class Epi, class Sched, bool ALIGN_EPI = false, bool SP2 = false>
__device__ __forceinline__ void gemm_phase(PG8_LAS unsigned char* lds, const Gemm g, const Sched& S, const Epi& E) {
    const int tid = threadIdx.x, wid = __builtin_amdgcn_readfirstlane(tid >> 6), lane = tid & 63, wr = wid >> 2, wc = wid & 3, fr = lane & 15, fq = lane >> 4;
    const int K = g.K, nt = K / BK;
    unsigned voffA[2], voffB[2];
#pragma unroll
    for (int i = 0; i < 2; ++i) { int R, C; stage_rc(tid * 16 + i * 8192, R, C); const int Rb = Epi::PERM ? ((R & ~31) + perm32(R & 31)) : R;
        voffA[i] = (unsigned)(R * K + C) * 2u; voffB[i] = (unsigned)(Rb * K + C) * 2u; }
    const size_t kstep = (size_t)(BK * 2);
    const size_t hstep = (size_t)HALF * K * 2;
    const size_t tstep = 2 * hstep;
    const unsigned ldsw = (unsigned)wid * 1024u;
    const int aoff = lds_byte(wr * 64 + fr, fq * 8), boff = lds_byte(wc * 32 + fr, fq * 8);
#define PG8_SA(b, h) (((b) * 2 + (h)) * HTB)
#define PG8_SB(b, h) ((4 + (b) * 2 + (h)) * HTB)
#define PG8_STAGE(bufoff, gbase, voff) do { _Pragma("unroll") for (int _i = 0; _i < 2; ++_i) \
        __builtin_amdgcn_global_load_lds((const unsigned*)((const char*)(gbase) + (voff)[_i]), (PG8_LAS unsigned*)(lds + (bufoff) + ldsw + _i * 8192), 16, 0, 0); } while (0)
#define PG8_LDA(dst, b, h) do { _Pragma("unroll") for (int m = 0; m < 4; ++m) _Pragma("unroll") for (int k = 0; k < 2; ++k) dst[m][k] = *(const PG8_LAS bf16x8*)(lds + PG8_SA(b, h) + aoff + m * 2048 + k * 1024); } while (0)
#define PG8_LDB(dst, b, h) do { _Pragma("unroll") for (int n = 0; n < 2; ++n) _Pragma("unroll") for (int k = 0; k < 2; ++k) dst[n][k] = *(const PG8_LAS bf16x8*)(lds + PG8_SB(b, h) + boff + n * 2048 + k * 1024); } while (0)
#define PG8_MMA(ai, bj, At, Bt) do { __builtin_amdgcn_s_setprio(1); _Pragma("unroll") for (int m = 0; m < 4; ++m) _Pragma("unroll") for (int n = 0; n < 2; ++n) _Pragma("unroll") for (int k = 0; k < 2; ++k) \
        acc[ai][bj][m][n] = __builtin_amdgcn_mfma_f32_16x16x32_bf16(Bt[n][k], At[m][k], acc[ai][bj][m][n], 0, 0, 0); __builtin_amdgcn_s_setprio(0); } while (0)
#define PG8_WAIT_V(n) asm volatile("s_waitcnt vmcnt(" #n ")" ::: "memory")
#define PG8_WAIT_L(n) asm volatile("s_waitcnt lgkmcnt(" #n ")" ::: "memory")
#define PG8_BAR __builtin_amdgcn_s_barrier()
#define PG8_SCHED __builtin_amdgcn_sched_barrier(0)
    Unit cur, nxt; int ui = 0;
    if (!S.next(0, cur)) return;
    f32x4 acc[2][2][4][2];
#pragma unroll
    for (int a = 0; a < 2; ++a)
#pragma unroll
        for (int b = 0; b < 2; ++b)
#pragma unroll
            for (int m = 0; m < 4; ++m)
#pragma unroll
                for (int n = 0; n < 2; ++n) acc[a][b][m][n] = (f32x4){0.f, 0.f, 0.f, 0.f};
    bf16x8 At[4][2], B0[2][2], B1[2][2];
    const char* cA = (const char*)g.A + (size_t)cur.pm * tstep; const char* cB = (const char*)g.Bt + (size_t)cur.pn * tstep;
    S.a_ready(cur);
    if constexpr (SP2) {
        PG8_STAGE(PG8_SB(0, 0), cB, voffB); PG8_STAGE(PG8_SB(0, 1), cB + hstep, voffB); PG8_STAGE(PG8_SA(0, 0), cA, voffA); PG8_STAGE(PG8_SA(0, 1), cA + hstep, voffA);
        if (wr == 1) PG8_BAR;
        PG8_WAIT_V(2); PG8_BAR;
        PG8_STAGE(PG8_SB(1, 0), cB + kstep, voffB); PG8_STAGE(PG8_SA(1, 0), cA + kstep, voffA); PG8_STAGE(PG8_SB(1, 1), cB + hstep + kstep, voffB);
        PG8_WAIT_V(6); PG8_BAR;
    } else {
        PG8_STAGE(PG8_SB(0, 0), cB, voffB); PG8_STAGE(PG8_SA(0, 0), cA, voffA); PG8_STAGE(PG8_SB(0, 1), cB + hstep, voffB); PG8_STAGE(PG8_SA(0, 1), cA + hstep, voffA);
        if (wr == 1) PG8_BAR;
        PG8_WAIT_V(4); PG8_BAR;
        PG8_STAGE(PG8_SB(1, 0), cB + kstep, voffB); PG8_STAGE(PG8_SA(1, 0), cA + kstep, voffA); PG8_STAGE(PG8_SB(1, 1), cB + hstep + kstep, voffB);
        PG8_WAIT_V(6); PG8_BAR;
    }
    for (;;) {
        const bool has_next = S.next(ui + 1, nxt);
        const char* nA = has_next ? (const char*)g.A + (size_t)nxt.pm * tstep : cA; const char* nB = has_next ? (const char*)g.Bt + (size_t)nxt.pn * tstep : cB;
        for (int t = 0; t < nt; t += 2) {
            const bool last = (t == nt - 2);
            const char* a1 = cA + (size_t)(t + 1) * kstep;
            const char* a2 = last ? nA : cA + (size_t)(t + 2) * kstep; const char* b2 = last ? nB : cB + (size_t)(t + 2) * kstep;
            const char* a3 = a2 + kstep; const char* b3 = b2 + kstep;
            if (last && has_next) S.a_ready(nxt);
            if constexpr (SP2) {
            PG8_LDB(B0, 0, 0); PG8_LDB(B1, 0, 1); PG8_SCHED; PG8_LDA(At, 0, 0); PG8_STAGE(PG8_SA(1, 1), a1 + hstep, voffA);
            PG8_WAIT_V(8); PG8_WAIT_L(0); PG8_BAR; PG8_MMA(0, 0, At, B0); PG8_MMA(0, 1, At, B1); PG8_BAR; PG8_SCHED;
            PG8_LDA(At, 0, 1); PG8_STAGE(PG8_SB(0, 0), b2, voffB); PG8_STAGE(PG8_SB(0, 1), b2 + hstep, voffB); PG8_STAGE(PG8_SA(0, 0), a2, voffA);
            PG8_WAIT_V(8); PG8_WAIT_L(0); PG8_BAR; PG8_MMA(1, 0, At, B0); PG8_MMA(1, 1, At, B1); PG8_BAR; PG8_SCHED;
            PG8_LDB(B0, 1, 0); PG8_LDB(B1, 1, 1); PG8_SCHED; PG8_LDA(At, 1, 0); PG8_STAGE(PG8_SA(0, 1), a2 + hstep, voffA);
            PG8_WAIT_V(8); PG8_WAIT_L(0); PG8_BAR; PG8_MMA(0, 0, At, B0); PG8_MMA(0, 1, At, B1); PG8_BAR; PG8_SCHED;
            PG8_LDA(At, 1, 1); PG8_STAGE(PG8_SB(1, 0), b3, voffB); PG8_STAGE(PG8_SB(1, 1), b3 + hstep, voffB); PG8_STAGE(PG8_SA(1, 0), a3, voffA);
            PG8_WAIT_V(8); PG8_WAIT_L(0); PG8_BAR; PG8_MMA(1, 0, At, B0); PG8_MMA(1, 1, At, B1); PG8_BAR; PG8_SCHED;
            } else {
            PG8_LDB(B0, 0, 0); PG8_SCHED; PG8_LDA(At, 0, 0); PG8_STAGE(PG8_SA(1, 1), a1 + hstep, voffA);
            PG8_WAIT_L(8); PG8_BAR; PG8_WAIT_L(0); PG8_MMA(0, 0, At, B0); PG8_BAR; PG8_SCHED;
            PG8_LDB(B1, 0, 1); PG8_STAGE(PG8_SB(0, 0), b2, voffB);
            PG8_BAR; PG8_WAIT_L(0); PG8_MMA(0, 1, At, B1); PG8_BAR;
            PG8_LDA(At, 0, 1); PG8_STAGE(PG8_SA(0, 0), a2, voffA);
            PG8_BAR; PG8_WAIT_L(0); PG8_MMA(1, 0, At, B0); PG8_BAR; PG8_SCHED;
            PG8_STAGE(PG8_SB(0, 1), b2 + hstep, voffB);
            PG8_WAIT_V(6); PG8_BAR; PG8_MMA(1, 1, At, B1); PG8_BAR;
            PG8_LDB(B0, 1, 0); PG8_SCHED; PG8_LDA(At, 1, 0); PG8_STAGE(PG8_SA(0, 1), a2 + hstep, voffA);
            PG8_WAIT_L(8); PG8_BAR; PG8_WAIT_L(0); PG8_MMA(0, 0, At, B0); PG8_BAR; PG8_SCHED;
            PG8_LDB(B1, 1, 1); PG8_STAGE(PG8_SB(1, 0), b3, voffB);
            PG8_BAR; PG8_WAIT_L(0); PG8_MMA(0, 1, At, B1); PG8_BAR;
            PG8_LDA(At, 1, 1); PG8_STAGE(PG8_SA(1, 0), a3, voffA);
            PG8_BAR; PG8_WAIT_L(0); PG8_MMA(1, 0, At, B0); PG8_BAR; PG8_SCHED;
            PG8_STAGE(PG8_SB(1, 1), b3 + hstep, voffB);
            PG8_WAIT_V(6); PG8_BAR; PG8_MMA(1, 1, At, B1); PG8_BAR;
            }
        }
        if constexpr (ALIGN_EPI) { if (wr == 0) PG8_BAR; }
        if constexpr (!Epi::AFTER_DRAIN) { E(acc, cur, wr, wc, fr, fq); S.done(cur); }
        if (!has_next) break;
#pragma unroll
        for (int a = 0; a < 2; ++a)
#pragma unroll
            for (int b = 0; b < 2; ++b)
#pragma unroll
                for (int m = 0; m < 4; ++m)
#pragma unroll
                    for (int n = 0; n < 2; ++n) acc[a][b][m][n] = (f32x4){0.f, 0.f, 0.f, 0.f};
        cur = nxt; cA = nA; cB = nB; ++ui;
        if constexpr (ALIGN_EPI) { if (wr == 1) PG8_BAR; }
    }
    PG8_WAIT_V(0);
    if constexpr (!ALIGN_EPI) { if (wr == 0) PG8_BAR; }
    PG8_BAR;
    if constexpr (Epi::AFTER_DRAIN) { E.fused(acc, cur, wr, wc, fr, fq, lds, wid, lane); S.done(cur); }
#undef PG8_SA
#undef PG8_SB
#undef PG8_STAGE
#undef PG8_LDA
#undef PG8_LDB
#undef PG8_MMA
#undef PG8_WAIT_V
#undef PG8_WAIT_L
#undef PG8_BAR
#undef PG8_SCHED
}
}
#ifndef PG8_SP2
#define PG8_SP2 true
#endif
#ifndef PG8_ALIGN
#define PG8_ALIGN true
#endif
constexpr int NWAVES = 8;
#ifndef REP_PHASE
#define REP_PHASE -1
#endif
#ifndef MK_MODE
#define MK_MODE 2
#endif
constexpr int BATCH = 4, SEQ = 2048, D = 2048, M = BATCH * SEQ, FF = 5632, NIN = 10240;
constexpr int DA_HEADS = 8, SB_HEADS = 16;
constexpr float SUBLN_EPS = 1e-5f, LAMBDA_INIT = 0.2f;
constexpr float C2 = 0.125f * 1.4426950408889634f;
constexpr size_t MiB = 1u << 20;
constexpr size_t WS_CTL = 0, CTL_ZERO_BYTES = 1 * MiB;
constexpr size_t WS_WGU1 = 2 * MiB, WS_WD1 = 46 * MiB, WS_WIN = 68 * MiB, WS_WA = 108 * MiB, WS_WB = 112 * MiB, WS_WOUT = 116 * MiB, WS_WGU2 = 124 * MiB, WS_WD2 = 168 * MiB;
constexpr size_t WS_XB = 190 * MiB;
constexpr size_t WS_H = 222 * MiB;
constexpr size_t WS_OA = 222 * MiB, WS_OB = 238 * MiB, WS_MG = 254 * MiB;
constexpr size_t WS_QKV = 310 * MiB, QKV_SPLIT = 16 * MiB;
constexpr size_t WS_G = 310 * MiB, WS_T = 342 * MiB;
constexpr size_t WS_END = 406 * MiB;
constexpr int CW_BAR = 4096;
constexpr int CW_SS2 = 32768, CW_SS3 = CW_SS2 + M, CW_SS4 = CW_SS3 + M, CW_RS1 = CW_SS4 + M;
static_assert((CW_RS1 + M) * 4 <= (int)CTL_ZERO_BYTES, "CTL words inside the memset region");
constexpr int RING_OFF = 0, RING_BYTES = 131072;
constexpr int LDSCTL_OFF = RING_BYTES, MISC_OFF = LDSCTL_OFF + 320;
constexpr int LDS_BYTES = 147456;

#define GAS __attribute__((address_space(1)))
#define LAS __attribute__((address_space(3)))
typedef unsigned short bf16;
typedef unsigned v4u __attribute__((ext_vector_type(4)));
typedef float f32x4 __attribute__((ext_vector_type(4)));
typedef short bf16x8 __attribute__((ext_vector_type(8)));
typedef GAS unsigned gu32;
typedef GAS unsigned long long gu64;
#define RLX_AGENT __ATOMIC_RELAXED, __HIP_MEMORY_SCOPE_AGENT
#define LDS_WAIT() asm volatile("s_waitcnt lgkmcnt(0)" ::: "memory")
#define VM_WAIT() asm volatile("s_waitcnt vmcnt(0)" ::: "memory")
__device__ __forceinline__ unsigned long long rt() { return __builtin_amdgcn_s_memrealtime(); }
__device__ __forceinline__ unsigned f2bf(float f) { unsigned u = __builtin_bit_cast(unsigned, f); return (u + 0x7fffu + ((u >> 16) & 1u)) >> 16; }
__device__ __forceinline__ unsigned pk2(float lo, float hi) { return f2bf(lo) | (f2bf(hi) << 16); }
#define XB_TMO      128
#define XB_XCNT(j)  (256  + 64 * (j))
#define XB_XSUB(j)  (1280 + 64 * (j))
#define XB_XGEN(j)  (2304 + 64 * (j))
#define XB_TOP      3328
#define XB_TOPGEN   3392
#define XCD_BAR_WORDS 3456
#define XB_SPIN_CAP (1u << 18)

__device__ __forceinline__ unsigned xb_ld(unsigned* p)              { return __hip_atomic_load(p, __ATOMIC_RELAXED, __HIP_MEMORY_SCOPE_AGENT); }
__device__ __forceinline__ unsigned xb_add(unsigned* p, unsigned v) { return __hip_atomic_fetch_add(p, v, __ATOMIC_RELAXED, __HIP_MEMORY_SCOPE_AGENT); }
__device__ __forceinline__ unsigned xb_xcc_id() { return (unsigned)__builtin_amdgcn_s_getreg((3 << 11) | 20) & 0xFu; }
#define XB_SPIN(cond, bar) do { unsigned _sp = 0; while (cond) { __builtin_amdgcn_s_sleep(1); \
    if ((++_sp & 255u) == 0u) { if (xb_ld(&(bar)[XB_TMO])) break; if (_sp > XB_SPIN_CAP) { atomicAdd(&(bar)[XB_TMO], 1u); break; } } } } while (0)

struct XcdBarrier {
    unsigned* bar; unsigned x;
    volatile LAS unsigned* st;
};

__device__ __forceinline__ XcdBarrier xcd_barrier_post(unsigned* bar, volatile LAS unsigned* st) {
    XcdBarrier b; b.bar = bar; b.x = xb_xcc_id(); b.st = st;
    if (threadIdx.x == 0) (void)xb_add(&bar[XB_XCNT(b.x)], 1u);
    return b;
}
__device__ __forceinline__ void xcd_barrier_complete(unsigned* bar, unsigned x, unsigned& nloc, unsigned& nx) {
    const unsigned G = gridDim.x * gridDim.y * gridDim.z;
    unsigned sum, cnt, mine, sp = 0u;
    for (;;) {
        sum = 0u; cnt = 0u; mine = 0u;
#pragma unroll
        for (unsigned j = 0; j < 16; ++j) { const unsigned c = xb_ld(&bar[XB_XCNT(j)]); sum += c; cnt += (c > 0u) ? 1u : 0u; mine = (j == x) ? c : mine; }
        if (sum == G) break;
        __builtin_amdgcn_s_sleep(1);
        if ((++sp & 255u) == 0u) { if (xb_ld(&bar[XB_TMO])) break; if (sp > XB_SPIN_CAP) { atomicAdd(&bar[XB_TMO], 1u); break; } }
    }
    nloc = mine > 0u ? mine : 1u; nx = cnt > 0u ? cnt : 1u;
}

__device__ __forceinline__ void xcd_barrier(const XcdBarrier& b) {
    asm volatile("s_waitcnt vmcnt(0)" ::: "memory");
    __syncthreads();
    if (threadIdx.x == 0) {
        unsigned* bar = b.bar;
        __builtin_amdgcn_s_waitcnt(0);
        unsigned nloc = b.st[0], nx = b.st[1];
        if (nloc == 0u) { xcd_barrier_complete(bar, b.x, nloc, nx); b.st[0] = nloc; b.st[1] = nx; }
        const unsigned old = xb_add(&bar[XB_XSUB(b.x)], 1u);
        const unsigned gen = old / nloc;
        if (old + 1u == (gen + 1u) * nloc) {
            __builtin_amdgcn_fence(__ATOMIC_RELEASE, "agent");
            asm volatile("s_waitcnt vmcnt(0)" ::: "memory");
            const unsigned og = xb_add(&bar[XB_TOP], 1u);
            const unsigned tg = og / nx;
            if (og + 1u == (tg + 1u) * nx) xb_add(&bar[XB_TOPGEN], 1u);
            else XB_SPIN(xb_ld(&bar[XB_TOPGEN]) == tg, bar);
            __builtin_amdgcn_fence(__ATOMIC_ACQUIRE, "agent");
            xb_add(&bar[XB_XGEN(b.x)], 1u);
            asm volatile("s_waitcnt vmcnt(0)" ::: "memory");
        } else {
            XB_SPIN(xb_ld(&bar[XB_XGEN(b.x)]) == gen, bar);
            __builtin_amdgcn_fence(__ATOMIC_ACQUIRE, "agent");
            asm volatile("s_waitcnt vmcnt(0)" ::: "memory");
        }
    }
    __syncthreads();
}
__device__ __forceinline__ float wave_sum(float v) {
#pragma unroll
    for (int o = 1; o < 64; o <<= 1) v += __shfl_xor(v, o);
    return v;
}
__device__ __forceinline__ float wave_max(float v) {
#pragma unroll
    for (int o = 1; o < 64; o <<= 1) v = fmaxf(v, __shfl_xor(v, o));
    return v;
}
typedef float f32x2_t __attribute__((ext_vector_type(2))); typedef __bf16 bf16x2_t __attribute__((ext_vector_type(2)));
__device__ __forceinline__ unsigned cvtpk(float lo, float hi) { f32x2_t v = {lo, hi}; bf16x2_t b = __builtin_convertvector(v, bf16x2_t); return __builtin_bit_cast(unsigned, b); }
template <bool GU>
__device__ __forceinline__ void p0_convert_item(const float* W, int K, int N, const float* gain, bf16* WT, int item, int lane) {
    const int nblk = N / 64, kb = item / nblk, nb = item % nblk, k0 = 64 * kb, n0 = 64 * nb;
    const int a = lane & 15, g = lane >> 4;
    const f32x4* src = (const f32x4*)(W + (size_t)(k0 + 16 * g) * N + n0 + 4 * a);
    f32x4 v[16];
#pragma unroll
    for (int i = 0; i < 16; ++i) v[i] = __builtin_nontemporal_load(src + (size_t)i * (N / 4));
    if (gain) {
        const f32x4* gp = (const f32x4*)(gain + k0 + 16 * g);
#pragma unroll
        for (int j = 0; j < 4; ++j) { const f32x4 gv = gp[j]; v[4 * j] *= gv[0]; v[4 * j + 1] *= gv[1]; v[4 * j + 2] *= gv[2]; v[4 * j + 3] *= gv[3]; }
    }
    int r0 = n0; if (GU) { r0 = (n0 < FF) ? (256 * (n0 / 128) + n0 % 128) : (256 * ((n0 - FF) / 128) + 128 + (n0 - FF) % 128); }
#pragma unroll
    for (int e = 0; e < 4; ++e) {
        v4u o0, o1;
        o0.x = cvtpk(v[0][e], v[1][e]); o0.y = cvtpk(v[2][e], v[3][e]); o0.z = cvtpk(v[4][e], v[5][e]); o0.w = cvtpk(v[6][e], v[7][e]);
        o1.x = cvtpk(v[8][e], v[9][e]); o1.y = cvtpk(v[10][e], v[11][e]); o1.z = cvtpk(v[12][e], v[13][e]); o1.w = cvtpk(v[14][e], v[15][e]);
        v4u* dst = (v4u*)(WT + (size_t)(r0 + 4 * a + e) * K + k0 + 16 * g); dst[0] = o0; dst[1] = o1;
    }
}

__device__ __forceinline__ int rel_bucket(int rel) {
    const int ret = rel > 0 ? 16 : 0; const int n = rel < 0 ? -rel : rel;
    int b;
    if (n < 8) b = n; else if (n < 12) b = 8; else if (n < 16) b = 9; else if (n < 23) b = 10; else if (n < 32) b = 11; else if (n < 46) b = 12; else if (n < 64) b = 13; else if (n < 91) b = 14; else b = 15;
    return ret + b;
}
__device__ __forceinline__ float bf2f(bf16 b) { return __uint_as_float(((unsigned)b) << 16); }
__global__ __launch_bounds__(128) void k_da_naive(const bf16* __restrict__ DQ, const bf16* __restrict__ DK, const bf16* __restrict__ DV, const float* __restrict__ rel_bias,
                                                  const float* lq1, const float* lk1, const float* lq2, const float* lk2, const float* subln, bf16* OA) {
    __shared__ float sS[2][2][SEQ];
    __shared__ float sQ[2][128];
    const int tid = threadIdx.x, w = tid >> 6, lane = tid & 63;
    const int gq = blockIdx.x * 2 + w; const int q = gq % SEQ, bh = gq / SEQ, h = bh % DA_HEADS, b = bh / DA_HEADS;
    const size_t m = (size_t)b * SEQ + q;
    sQ[w][lane] = bf2f(DQ[m * 1024 + h * 128 + lane]); sQ[w][lane + 64] = bf2f(DQ[m * 1024 + h * 128 + 64 + lane]);
    const float lam = __expf(wave_sum(lq1[lane] * lk1[lane])) - __expf(wave_sum(lq2[lane] * lk2[lane])) + LAMBDA_INIT;
    __syncthreads();
    const int nk = (q / 64 + 1) * 64;
    float mx0 = -INFINITY, mx1 = -INFINITY;
    for (int k = lane; k < nk; k += 64) {
        const bf16* kr = DK + ((size_t)b * SEQ + k) * 1024 + h * 128;
        float s0 = 0.f, s1 = 0.f;
#pragma unroll
        for (int c = 0; c < 8; ++c) {
            const uint4 v0 = *(const uint4*)(kr + c * 8), v1 = *(const uint4*)(kr + 64 + c * 8);
            const unsigned a0[4] = {v0.x, v0.y, v0.z, v0.w}, a1[4] = {v1.x, v1.y, v1.z, v1.w};
#pragma unroll
            for (int e = 0; e < 4; ++e) {
                s0 += sQ[w][c * 8 + 2 * e] * __uint_as_float(a0[e] << 16) + sQ[w][c * 8 + 2 * e + 1] * __uint_as_float(a0[e] & 0xffff0000u);
                s1 += sQ[w][64 + c * 8 + 2 * e] * __uint_as_float(a1[e] << 16) + sQ[w][64 + c * 8 + 2 * e + 1] * __uint_as_float(a1[e] & 0xffff0000u);
            }
        }
        const int bk = rel_bucket(k - q);
        s0 = s0 + 1.4426950408889634f * rel_bias[bk * 16 + h * 2 + 0]; s1 = s1 + 1.4426950408889634f * rel_bias[bk * 16 + h * 2 + 1];
        sS[w][0][k] = s0; sS[w][1][k] = s1; mx0 = fmaxf(mx0, s0); mx1 = fmaxf(mx1, s1);
    }
    mx0 = wave_max(mx0); mx1 = wave_max(mx1);
    float l0 = 0.f, l1 = 0.f;
    for (int k = lane; k < nk; k += 64) { const float p0 = exp2f(sS[w][0][k] - mx0), p1 = exp2f(sS[w][1][k] - mx1); sS[w][0][k] = p0; sS[w][1][k] = p1; l0 += p0; l1 += p1; }
    l0 = wave_sum(l0); l1 = wave_sum(l1);
    const float i0 = 1.0f / l0, i1 = lam / l1;
    for (int k = lane; k < nk; k += 64) sS[w][0][k] = sS[w][0][k] * i0 - sS[w][1][k] * i1;
    __syncthreads();
    float o0 = 0.f, o1 = 0.f;
    const bf16* vb = DV + (size_t)b * SEQ * 1024 + h * 128 + 2 * lane;
    for (int k = 0; k < nk; ++k) { const float a = sS[w][0][k]; const unsigned vv = *(const unsigned*)(vb + (size_t)k * 1024); o0 += a * __uint_as_float(vv << 16); o1 += a * __uint_as_float(vv & 0xffff0000u); }
    const float ss = wave_sum(o0 * o0 + o1 * o1);
    const float r = rsqrtf(ss * (1.0f / 128.0f) + SUBLN_EPS) * (1.0f - LAMBDA_INIT);
    *(unsigned*)(OA + m * 1024 + h * 128 + 2 * lane) = pk2(o0 * r * subln[2 * lane], o1 * r * subln[2 * lane + 1]);
}
__global__ __launch_bounds__(256) void k_sb_naive(const bf16* __restrict__ SQ, const bf16* __restrict__ SK, const bf16* __restrict__ SV, bf16* OB) {
    __shared__ float sW[4][SEQ];
    __shared__ float sQ[4][64];
    const int tid = threadIdx.x, w = tid >> 6, lane = tid & 63;
    const int gq = blockIdx.x * 4 + w; const int q = gq % SEQ, bh = gq / SEQ, h = bh % SB_HEADS, b = bh / SB_HEADS;
    const size_t m = (size_t)b * SEQ + q;
    sQ[w][lane] = bf2f(SQ[m * 1024 + h * 64 + lane]);
    __syncthreads();
    const int nchunk = (q + 63) / 64;
    float carry = 0.f;
    for (int c = nchunk - 1; c >= 0; --c) {
        const int j = c * 64 + lane; const bool valid = j < q;
        const bf16* kr = SK + ((size_t)b * SEQ + j) * 1024 + h * 64;
        float z = 0.f;
#pragma unroll
        for (int cc = 0; cc < 8; ++cc) {
            const uint4 v0 = *(const uint4*)(kr + cc * 8); const unsigned a0[4] = {v0.x, v0.y, v0.z, v0.w};
#pragma unroll
            for (int e = 0; e < 4; ++e) z += sQ[w][cc * 8 + 2 * e] * __uint_as_float(a0[e] << 16) + sQ[w][cc * 8 + 2 * e + 1] * __uint_as_float(a0[e] & 0xffff0000u);
        }
        z *= 0.6931471805599453f;
        const float sp = fmaxf(z, 0.f) + log1pf(__expf(-fabsf(z)));
        const float lk = valid ? -sp : 0.f;
        float incl = lk;
#pragma unroll
        for (int off = 1; off < 64; off <<= 1) { const float t = __shfl_down(incl, off); incl += (lane + off < 64) ? t : 0.f; }
        const float lb = carry + incl - lk;
        sW[w][j] = valid ? __expf((z - sp) + lb) : 0.f;
        carry += __shfl(incl, 0);
    }
    __syncthreads();
    float o = 0.f;
    const bf16* vb = SV + (size_t)b * SEQ * 1024 + h * 64 + lane;
    const int nkp = nchunk * 64;
    for (int k = 0; k < nkp; ++k) o += sW[w][k] * bf2f(vb[(size_t)k * 1024]);
    OB[m * 1024 + h * 64 + lane] = (bf16)f2bf(o);
}


__device__ __forceinline__ void da_row_naive(LAS float* sS  , LAS float* sQ  , int b, int h, int q, int lane, float lam, const bf16* __restrict__ DQ, const bf16* __restrict__ DK, const bf16* __restrict__ DV,
                                             const float* __restrict__ rel_bias, const float* subln, bf16* OA) {
    const size_t m = (size_t)b * SEQ + q;
    sQ[lane] = bf2f(DQ[m * 1024 + h * 128 + lane]); sQ[lane + 64] = bf2f(DQ[m * 1024 + h * 128 + 64 + lane]);
    LDS_WAIT(); asm volatile("" ::: "memory");
    const int nk = (q / 64 + 1) * 64;
    float mx0 = -INFINITY, mx1 = -INFINITY;
    for (int k = lane; k < nk; k += 64) {
        const bf16* kr = DK + ((size_t)b * SEQ + k) * 1024 + h * 128;
        float s0 = 0.f, s1 = 0.f;
#pragma unroll
        for (int c = 0; c < 8; ++c) {
            const uint4 v0 = *(const uint4*)(kr + c * 8), v1 = *(const uint4*)(kr + 64 + c * 8);
            const unsigned a0[4] = {v0.x, v0.y, v0.z, v0.w}, a1[4] = {v1.x, v1.y, v1.z, v1.w};
#pragma unroll
            for (int e = 0; e < 4; ++e) {
                s0 += sQ[c * 8 + 2 * e] * __uint_as_float(a0[e] << 16) + sQ[c * 8 + 2 * e + 1] * __uint_as_float(a0[e] & 0xffff0000u);
                s1 += sQ[64 + c * 8 + 2 * e] * __uint_as_float(a1[e] << 16) + sQ[64 + c * 8 + 2 * e + 1] * __uint_as_float(a1[e] & 0xffff0000u);
            }
        }
        const int bk = rel_bucket(k - q);
        s0 = s0 + 1.4426950408889634f * rel_bias[bk * 16 + h * 2 + 0]; s1 = s1 + 1.4426950408889634f * rel_bias[bk * 16 + h * 2 + 1];
        sS[k] = s0; sS[SEQ + k] = s1; mx0 = fmaxf(mx0, s0); mx1 = fmaxf(mx1, s1);
    }
    mx0 = wave_max(mx0); mx1 = wave_max(mx1);
    float l0 = 0.f, l1 = 0.f;
    for (int k = lane; k < nk; k += 64) { const float p0 = exp2f(sS[k] - mx0), p1 = exp2f(sS[SEQ + k] - mx1); sS[k] = p0; sS[SEQ + k] = p1; l0 += p0; l1 += p1; }
    l0 = wave_sum(l0); l1 = wave_sum(l1);
    const float i0 = 1.0f / l0, i1 = lam / l1;
    for (int k = lane; k < nk; k += 64) sS[k] = sS[k] * i0 - sS[SEQ + k] * i1;
    LDS_WAIT(); asm volatile("" ::: "memory");
    float o0 = 0.f, o1 = 0.f;
    const bf16* vb = DV + (size_t)b * SEQ * 1024 + h * 128 + 2 * lane;
    for (int k = 0; k < nk; ++k) { const float a = sS[k]; const unsigned vv = *(const unsigned*)(vb + (size_t)k * 1024); o0 += a * __uint_as_float(vv << 16); o1 += a * __uint_as_float(vv & 0xffff0000u); }
    const float ss = wave_sum(o0 * o0 + o1 * o1);
    const float r = rsqrtf(ss * (1.0f / 128.0f) + SUBLN_EPS) * (1.0f - LAMBDA_INIT);
    *(unsigned*)(OA + m * 1024 + h * 128 + 2 * lane) = pk2(o0 * r * subln[2 * lane], o1 * r * subln[2 * lane + 1]);
    LDS_WAIT(); asm volatile("" ::: "memory");
}
__device__ __forceinline__ void sb_row_naive(LAS float* sW  , LAS float* sQ  , int b, int h, int q, int lane, const bf16* __restrict__ SQ, const bf16* __restrict__ SK, const bf16* __restrict__ SV, bf16* OB) {
    const size_t m = (size_t)b * SEQ + q;
    sQ[lane] = bf2f(SQ[m * 1024 + h * 64 + lane]);
    LDS_WAIT(); asm volatile("" ::: "memory");
    const int nchunk = (q + 63) / 64;
    float carry = 0.f;
    for (int c = nchunk - 1; c >= 0; --c) {
        const int j = c * 64 + lane; const bool valid = j < q;
        const bf16* kr = SK + ((size_t)b * SEQ + j) * 1024 + h * 64;
        float z = 0.f;
#pragma unroll
        for (int cc = 0; cc < 8; ++cc) {
            const uint4 v0 = *(const uint4*)(kr + cc * 8); const unsigned a0[4] = {v0.x, v0.y, v0.z, v0.w};
#pragma unroll
            for (int e = 0; e < 4; ++e) z += sQ[cc * 8 + 2 * e] * __uint_as_float(a0[e] << 16) + sQ[cc * 8 + 2 * e + 1] * __uint_as_float(a0[e] & 0xffff0000u);
        }
        z *= 0.6931471805599453f;
        const float sp = fmaxf(z, 0.f) + log1pf(__expf(-fabsf(z)));
        const float lk = valid ? -sp : 0.f;
        float incl = lk;
#pragma unroll
        for (int off = 1; off < 64; off <<= 1) { const float t = __shfl_down(incl, off); incl += (lane + off < 64) ? t : 0.f; }
        const float lb = carry + incl - lk;
        sW[j] = valid ? __expf((z - sp) + lb) : 0.f;
        carry += __shfl(incl, 0);
    }
    LDS_WAIT(); asm volatile("" ::: "memory");
    float o = 0.f;
    const bf16* vb = SV + (size_t)b * SEQ * 1024 + h * 64 + lane;
    const int nkp = nchunk * 64;
    for (int k = 0; k < nkp; ++k) o += sW[k] * bf2f(vb[(size_t)k * 1024]);
    OB[m * 1024 + h * 64 + lane] = (bf16)f2bf(o);
    LDS_WAIT(); asm volatile("" ::: "memory");
}

namespace att {
typedef __attribute__((ext_vector_type(8))) short bf16x8;
typedef __attribute__((ext_vector_type(4))) short s16x4;
typedef __attribute__((ext_vector_type(16))) float f32x16;
typedef __attribute__((ext_vector_type(4))) unsigned u32x4;
typedef __attribute__((address_space(3))) const char* lds_cptr;
#define ATT_LAS __attribute__((address_space(3)))
#define SBAR() __builtin_amdgcn_sched_barrier(0)
#define WAIT_BAR0() asm volatile("s_waitcnt vmcnt(0) lgkmcnt(0)\n\ts_barrier" ::: "memory")
#define LDS_BAR() asm volatile("s_waitcnt lgkmcnt(0)\n\ts_barrier" ::: "memory")
__device__ __forceinline__ int crowc(int r) { return (r & 3) + 8 * (r >> 2); }
__device__ __forceinline__ void glds16(const void* gsrc, unsigned lds_dst) { unsigned keep;
    asm volatile("s_mov_b32 %0, m0\n\ts_mov_b32 m0, %2\n\ts_nop 0\n\tglobal_load_lds_dwordx4 %1, off\n\ts_mov_b32 m0, %0" : "=&s"(keep) : "v"(gsrc), "s"(lds_dst) : "memory"); }
typedef float f32x2_t __attribute__((ext_vector_type(2))); typedef __bf16 bf16x2_t __attribute__((ext_vector_type(2)));
__device__ __forceinline__ unsigned cvtpk_s(float lo, float hi) { f32x2_t v = {lo, hi}; bf16x2_t b = __builtin_convertvector(v, bf16x2_t); return __builtin_bit_cast(unsigned, b); }
__device__ __forceinline__ void qkt(f32x16& p0, f32x16& p1, lds_cptr Kslot, const bf16x8* qr, const f32x16& cinit, int r32, int hi) {
    lds_cptr kb = Kslot + hi * 1024 + r32 * 16;
#pragma unroll
    for (int d0 = 0; d0 < 4; ++d0) {
        const bf16x8 b0 = *(const ATT_LAS bf16x8*)(kb + d0 * 2048);
        const bf16x8 b1 = *(const ATT_LAS bf16x8*)(kb + d0 * 2048 + 512);
        if (d0 == 0) { p0 = __builtin_amdgcn_mfma_f32_32x32x16_bf16(b0, qr[0], cinit, 0, 0, 0); p1 = __builtin_amdgcn_mfma_f32_32x32x16_bf16(b1, qr[0], cinit, 0, 0, 0); }
        else { p0 = __builtin_amdgcn_mfma_f32_32x32x16_bf16(b0, qr[d0], p0, 0, 0, 0); p1 = __builtin_amdgcn_mfma_f32_32x32x16_bf16(b1, qr[d0], p1, 0, 0, 0); } }
}
__device__ __forceinline__ void pv(f32x16* o, int vb, bf16x8 pa0, bf16x8 pa1, bf16x8 pa2, bf16x8 pa3) {
#pragma unroll
    for (int d0 = 0; d0 < 2; ++d0) { s16x4 lo[4], hi[4];
#pragma unroll
        for (int ks = 0; ks < 4; ++ks) {
            asm volatile("ds_read_b64_tr_b16 %0,%1 offset:%c2" : "=&v"(lo[ks]) : "v"(vb), "i"(d0 * 4096 + ks * 1024) : "memory");
            asm volatile("ds_read_b64_tr_b16 %0,%1 offset:%c2" : "=&v"(hi[ks]) : "v"(vb), "i"(d0 * 4096 + ks * 1024 + 512) : "memory"); }
        asm volatile("s_waitcnt lgkmcnt(0)" ::: "memory"); SBAR();
#define PK(k) (bf16x8){lo[k][0], lo[k][1], lo[k][2], lo[k][3], hi[k][0], hi[k][1], hi[k][2], hi[k][3]}
        o[d0] = __builtin_amdgcn_mfma_f32_32x32x16_bf16(pa0, PK(0), o[d0], 0, 0, 0);
        o[d0] = __builtin_amdgcn_mfma_f32_32x32x16_bf16(pa1, PK(1), o[d0], 0, 0, 0);
        o[d0] = __builtin_amdgcn_mfma_f32_32x32x16_bf16(pa2, PK(2), o[d0], 0, 0, 0);
        o[d0] = __builtin_amdgcn_mfma_f32_32x32x16_bf16(pa3, PK(3), o[d0], 0, 0, 0);
#undef PK
    }
}
#define PKW(P, B) cvtpk_s(P[B], P[(B) + 1])
#define PACK_P(P0, P1) do { pw0 = (u32x4){PKW(P0, 0), PKW(P0, 2), PKW(P0, 4), PKW(P0, 6)}; pw1 = (u32x4){PKW(P0, 8), PKW(P0, 10), PKW(P0, 12), PKW(P0, 14)}; \
                            pw2 = (u32x4){PKW(P1, 0), PKW(P1, 2), PKW(P1, 4), PKW(P1, 6)}; pw3 = (u32x4){PKW(P1, 8), PKW(P1, 10), PKW(P1, 12), PKW(P1, 14)}; } while (0)
#define PAF(k) __builtin_bit_cast(bf16x8, pw##k)

__device__ __forceinline__ void sb_unit(int b, int h, int qb, const bf16* SQ, const bf16* __restrict__ SK, const bf16* __restrict__ SV, bf16* OB, ATT_LAS unsigned char* Lb) {
    const int tid = threadIdx.x, lane = tid & 63, r32 = lane & 31, hi = lane >> 5; const int wid = __builtin_amdgcn_readfirstlane(tid >> 6);
    const long rowbase = (long)b * SEQ; const int q0 = qb * 256;
    const bf16* Qw = SQ + (rowbase + q0 + wid * 32) * 1024 + h * 64;
    const bf16* Kh = SK + rowbase * 1024 + h * 64; const bf16* Vh = SV + rowbase * 1024 + h * 64;
    const unsigned lds0 = (unsigned)(uintptr_t)Lb;
    const bf16* ksrc = Kh + (long)lane * 1024 + wid * 8;
    const bf16* vsrc = Vh + (long)(16 * (wid & 3) + (lane >> 2)) * 1024 + (wid >> 2) * 32 + (lane & 3) * 8;
    const unsigned kdst = lds0 + wid * 1024, vdst = lds0 + 8192 + wid * 1024;
#define DMA_K(t, slot) glds16(ksrc + (long)(t) * 64 * 1024, (unsigned)__builtin_amdgcn_readfirstlane(kdst + (slot)))
#define DMA_V(t, slot) glds16(vsrc + (long)(t) * 64 * 1024, (unsigned)__builtin_amdgcn_readfirstlane(vdst + (slot)))
    const int vb0 = (int)(lds0 + 8192) + ((lane >> 4) & 1) * 32 + (lane & 3) * 8 + (4 * hi + ((lane & 15) >> 2)) * 64;
    const int NT = 4 * (qb + 1);
    DMA_K(NT - 1, 0); DMA_V(NT - 1, 0);
    bf16x8 qr[4];
#pragma unroll
    for (int d0 = 0; d0 < 4; ++d0) qr[d0] = *reinterpret_cast<const bf16x8*>(&Qw[(long)r32 * 1024 + d0 * 16 + hi * 8]);
    f32x16 o[2]; o[0] = f32x16{}; o[1] = f32x16{};
    const f32x16 zero = f32x16{};
    float R = 0.f;
    const int qrel = wid * 32 + r32;
    ATT_LAS unsigned* flg = (ATT_LAS unsigned*)(Lb + 98304);
    for (int n = 0; n < NT; ++n) {
        const int t = NT - 1 - n; const int slot = (n & 1) * 16384;
        WAIT_BAR0();
        if (n > 0) { const ATT_LAS unsigned* f = flg + ((n - 1) & 1) * 8;
            const unsigned all_done = (f[0] & f[1]) & (f[2] & f[3]) & (f[4] & f[5]) & (f[6] & f[7]);
            if (__builtin_amdgcn_readfirstlane(all_done)) break; }
        if (n + 1 < NT) { DMA_K(t - 1, slot ^ 16384); DMA_V(t - 1, slot ^ 16384); }
        const int jb = t - 4 * qb;
        const bool skip = (jb >= 0) && (64 * jb > 32 * wid + 30);
        if (!skip) {
            const bool partial = (jb >= 0) && !(64 * jb + 63 < 32 * wid);
            f32x16 p0, p1;
            qkt(p0, p1, (lds_cptr)(Lb + slot), qr, zero, r32, hi);
            const int kb = 64 * jb + 4 * hi;
            float lk0[16], lk1[16];
#pragma unroll
            for (int r = 0; r < 16; ++r) {
                { const float y = p0[r]; const float sp = fmaxf(y, 0.f) + __builtin_amdgcn_logf(1.0f + __builtin_amdgcn_exp2f(-fabsf(y)));
                  const bool v = !partial || (kb + crowc(r) < qrel); lk0[r] = v ? -sp : 0.f; p0[r] = v ? (y - sp) : -INFINITY; }
                { const float y = p1[r]; const float sp = fmaxf(y, 0.f) + __builtin_amdgcn_logf(1.0f + __builtin_amdgcn_exp2f(-fabsf(y)));
                  const bool v = !partial || (kb + 32 + crowc(r) < qrel); lk1[r] = v ? -sp : 0.f; p1[r] = v ? (y - sp) : -INFINITY; }
            }
            float G[8], PG[8], S8[8];
#pragma unroll
            for (int gi = 0; gi < 4; ++gi) { G[gi] = (lk0[4 * gi] + lk0[4 * gi + 1]) + (lk0[4 * gi + 2] + lk0[4 * gi + 3]); G[4 + gi] = (lk1[4 * gi] + lk1[4 * gi + 1]) + (lk1[4 * gi + 2] + lk1[4 * gi + 3]); }
#pragma unroll
            for (int gi = 0; gi < 8; ++gi) PG[gi] = __shfl_xor(G[gi], 32);
            S8[7] = 0.f;
#pragma unroll
            for (int gi = 6; gi >= 0; --gi) S8[gi] = S8[gi + 1] + (G[gi + 1] + PG[gi + 1]);
            const float total = S8[0] + (G[0] + PG[0]);
#pragma unroll
            for (int gi = 0; gi < 8; ++gi) {
                const float s3 = R + S8[gi] + (hi ? 0.f : PG[gi]);
                if (gi < 4) { const float s2 = s3 + lk0[4 * gi + 3], s1 = s2 + lk0[4 * gi + 2], s0 = s1 + lk0[4 * gi + 1];
                    p0[4 * gi + 3] = __builtin_amdgcn_exp2f(p0[4 * gi + 3] + s3); p0[4 * gi + 2] = __builtin_amdgcn_exp2f(p0[4 * gi + 2] + s2);
                    p0[4 * gi + 1] = __builtin_amdgcn_exp2f(p0[4 * gi + 1] + s1); p0[4 * gi] = __builtin_amdgcn_exp2f(p0[4 * gi] + s0); }
                else { const int g4 = gi - 4; const float s2 = s3 + lk1[4 * g4 + 3], s1 = s2 + lk1[4 * g4 + 2], s0 = s1 + lk1[4 * g4 + 1];
                    p1[4 * g4 + 3] = __builtin_amdgcn_exp2f(p1[4 * g4 + 3] + s3); p1[4 * g4 + 2] = __builtin_amdgcn_exp2f(p1[4 * g4 + 2] + s2);
                    p1[4 * g4 + 1] = __builtin_amdgcn_exp2f(p1[4 * g4 + 1] + s1); p1[4 * g4] = __builtin_amdgcn_exp2f(p1[4 * g4] + s0); }
            }
            R += total;
            u32x4 pw0, pw1, pw2, pw3; PACK_P(p0, p1);
            SBAR(); pv(o, vb0 + slot, PAF(0), PAF(1), PAF(2), PAF(3));
        }
        {   const bool done = !skip && __all(R < -100.0f);
            if (lane == 0) flg[(n & 1) * 8 + wid] = done ? 1u : 0u; }
    }
    bf16* Ow = OB + (rowbase + q0 + wid * 32) * 1024 + h * 64;
    {   ATT_LAS bf16* stg = (ATT_LAS bf16*)(Lb + 65536) + wid * 2048;
#pragma unroll
        for (int r = 0; r < 16; ++r) { const int orow = crowc(r) + 4 * hi;
#pragma unroll
            for (int d0 = 0; d0 < 2; ++d0) stg[orow * 64 + d0 * 32 + r32] = (bf16)f2bf(o[d0][r]); }
        asm volatile("s_waitcnt lgkmcnt(0)" ::: "memory");
#pragma unroll
        for (int i = 0; i < 4; ++i) { const int row = i * 8 + (lane >> 3), ch = lane & 7; const u32x4 v = *(const ATT_LAS u32x4*)(stg + row * 64 + ch * 8); *(u32x4*)(Ow + (long)row * 1024 + ch * 8) = v; } }
    LDS_BAR();
#undef DMA_K
#undef DMA_V
}

__device__ __forceinline__ void da_unit(int b, int h, int iu, const bf16* DQ, const bf16* __restrict__ DK, const bf16* __restrict__ DV, bf16* OA, ATT_LAS unsigned char* Lb, ATT_LAS float* TB, ATT_LAS float* wsf_all,
                                        const float* __restrict__ rel_bias, const float* __restrict__ subln, float lam) {
    const int tid = threadIdx.x, lane = tid & 63, r32 = lane & 31, hi = lane >> 5; const int wid = __builtin_amdgcn_readfirstlane(tid >> 6);
    const int qblk = wid & 3, mp = wid >> 2;
    const long rowbase = (long)b * SEQ; const int q0 = iu * 128;
    const int c = 2 * iu + (qblk >> 1);
    const int qc = 32 * (qblk & 1) + r32;
    ATT_LAS float* wsf = wsf_all + wid * 64;
    {   const int mm = tid >> 8, i = tid & 255; const int rel = i - 191;
        TB[mm * 256 + i] = (i < 255) ? rel_bias[rel_bucket(rel) * 16 + 2 * h + mm] * 1.4426950408889634f : 0.f; }
    const float bfar = rel_bias[15 * 16 + 2 * h + mp] * 1.4426950408889634f;
    const bf16* Qw = DQ + (rowbase + q0 + 32 * qblk) * 1024 + h * 128 + mp * 64;
    const unsigned lds0 = (unsigned)(uintptr_t)Lb;
    const bf16* ksrc = DK + (rowbase + lane) * 1024 + h * 128 + wid * 8;
    const bf16* vsrc = DV + (rowbase + 16 * (wid & 3) + (lane >> 2)) * 1024 + h * 128 + (wid >> 2) * 32 + (lane & 3) * 8;
    const unsigned pdst = lds0 + wid * 1024;
#define DMA_TILE(t, slot) do { const unsigned d_ = (unsigned)__builtin_amdgcn_readfirstlane(pdst + (slot)); const long to_ = (long)(t) * 64 * 1024; \
        glds16(ksrc + to_, d_); glds16(ksrc + to_ + 64, d_ + 8192); glds16(vsrc + to_, d_ + 16384); glds16(vsrc + to_ + 64, d_ + 24576); } while (0)
    const int vb0 = (int)(lds0 + 16384) + ((lane >> 4) & 1) * 32 + (lane & 3) * 8 + (4 * hi + ((lane & 15) >> 2)) * 64;
    const int NT = 2 * iu + 2;
    DMA_TILE(0, 0);
    bf16x8 qr[4];
#pragma unroll
    for (int d0 = 0; d0 < 4; ++d0) qr[d0] = *reinterpret_cast<const bf16x8*>(&Qw[(long)r32 * 1024 + d0 * 16 + hi * 8]);
    f32x16 o[4]; o[0] = f32x16{}; o[1] = f32x16{}; o[2] = f32x16{}; o[3] = f32x16{};
    float mrun = -1e30f, lsum = 0.f;
    for (int n = 0; n < NT; ++n) {
        const int t = n; const int slot = (n & 1) * 32768;
        WAIT_BAR0();
        if (n + 1 < NT) DMA_TILE(t + 1, slot ^ 32768);
        if (t <= c) {
            const bool near = (t >= c - 2);
            const float ci = near ? 0.f : bfar;
            f32x16 cinit;
#pragma unroll
            for (int r = 0; r < 16; ++r) cinit[r] = ci;
            f32x16 p0, p1;
            qkt(p0, p1, (lds_cptr)(Lb + slot + mp * 8192), qr, cinit, r32, hi);
            if (near) {
                const ATT_LAS float* tbp = TB + mp * 256 + (64 * (t - c + 2) + 63 - qc + 4 * hi);
#pragma unroll
                for (int r = 0; r < 16; ++r) { p0[r] += tbp[crowc(r)]; p1[r] += tbp[32 + crowc(r)]; }
            }
            float rm = fmaxf(p0[0], p1[0]);
#pragma unroll
            for (int r = 1; r < 16; ++r) rm = fmaxf(rm, fmaxf(p0[r], p1[r]));
            rm = fmaxf(rm, __shfl_xor(rm, 32));
            const float mnew = fmaxf(mrun, rm); const float f = __builtin_amdgcn_exp2f(mrun - mnew); mrun = mnew;
            if (hi == 0) wsf[r32] = f;
            float ps = 0.f;
#pragma unroll
            for (int r = 0; r < 16; ++r) { p0[r] = __builtin_amdgcn_exp2f(p0[r] - mnew); p1[r] = __builtin_amdgcn_exp2f(p1[r] - mnew); ps += p0[r] + p1[r]; }
            lsum = lsum * f + ps;
            asm volatile("s_waitcnt lgkmcnt(0)" ::: "memory");
#pragma unroll
            for (int r = 0; r < 16; ++r) { const float fr_ = wsf[crowc(r) + 4 * hi];
#pragma unroll
                for (int d = 0; d < 4; ++d) o[d][r] *= fr_; }
            u32x4 pw0, pw1, pw2, pw3; PACK_P(p0, p1);
            SBAR(); pv(o, vb0 + slot, PAF(0), PAF(1), PAF(2), PAF(3));
            SBAR(); pv(o + 2, vb0 + slot + 8192, PAF(0), PAF(1), PAF(2), PAF(3));
        }
    }
    {   const float lt = lsum + __shfl_xor(lsum, 32); float inv = 1.0f / lt; if (mp == 1) inv *= lam;
        asm volatile("s_waitcnt lgkmcnt(0)" ::: "memory");
        if (hi == 0) wsf[r32] = inv;
        asm volatile("s_waitcnt lgkmcnt(0)" ::: "memory");
#pragma unroll
        for (int r = 0; r < 16; ++r) { const float fr_ = wsf[crowc(r) + 4 * hi];
#pragma unroll
            for (int d = 0; d < 4; ++d) o[d][r] *= fr_; } }
    LDS_BAR();
    ATT_LAS float* X = (ATT_LAS float*)Lb + (size_t)qblk * (4 * 16 * 64) + lane;
    if (mp == 1) {
#pragma unroll
        for (int d = 0; d < 4; ++d)
#pragma unroll
            for (int r = 0; r < 16; ++r) X[(d * 16 + r) * 64] = o[d][r];
    }
    LDS_BAR();
    if (mp == 0) {
        float ssq[16];
#pragma unroll
        for (int r = 0; r < 16; ++r) { float s = 0.f;
#pragma unroll
            for (int d = 0; d < 4; ++d) { o[d][r] -= X[(d * 16 + r) * 64]; s += o[d][r] * o[d][r]; }
            ssq[r] = s; }
#pragma unroll
        for (int r = 0; r < 16; ++r) {
#pragma unroll
            for (int off = 1; off < 32; off <<= 1) ssq[r] += __shfl_xor(ssq[r], off);
            ssq[r] = rsqrtf(ssq[r] * (1.0f / 128.0f) + SUBLN_EPS) * (1.0f - LAMBDA_INIT); }
        ATT_LAS bf16* stg = (ATT_LAS bf16*)(Lb + 65536) + qblk * 4096;
#pragma unroll
        for (int d = 0; d < 4; ++d) { const float gsub = subln[32 * d + r32];
#pragma unroll
            for (int r = 0; r < 16; ++r) stg[(crowc(r) + 4 * hi) * 128 + 32 * d + r32] = (bf16)f2bf(o[d][r] * ssq[r] * gsub); }
        asm volatile("s_waitcnt lgkmcnt(0)" ::: "memory");
        bf16* Ow = OA + (rowbase + q0 + 32 * qblk) * 1024 + h * 128;
#pragma unroll
        for (int i = 0; i < 8; ++i) { const int row = i * 4 + (lane >> 4), ch = lane & 15; const u32x4 v = *(const ATT_LAS u32x4*)(stg + row * 128 + ch * 8); *(u32x4*)(Ow + (long)row * 1024 + ch * 8) = v; }
    }
    LDS_BAR();
#undef DMA_TILE
}
#undef PKW
#undef PACK_P
#undef PAF
#undef SBAR
#undef WAIT_BAR0
#undef LDS_BAR
}

struct Args { const float* in[19]; float* out; unsigned char* ws; int ph_lo, ph_hi, li, pad; };
constexpr int N_PHASES = 10;
__global__ void __launch_bounds__(NWAVES * 64, 2) mega_fwd(Args args) {
    extern __shared__ __attribute__((aligned(16))) unsigned char lds[];
    LAS unsigned char* const L = (LAS unsigned char*)lds;
    volatile LAS unsigned* const MISC = (volatile LAS unsigned*)(L + MISC_OFF);
    const int tid = threadIdx.x, lane = tid & 63, wave = __builtin_amdgcn_readfirstlane(tid >> 6);
    const int G = gridDim.x; const int bx = blockIdx.x; const int vcu = (G % 8 == 0) ? (bx % 8) * (G / 8) + bx / 8 : bx;
    unsigned char* const ws = args.ws;
    gu32* const ctl = (gu32*)(ws + WS_CTL);
    const float* const x = args.in[0];
    float* const out = args.out;
    bf16* const XB = (bf16*)(ws + WS_XB); bf16* const HB = (bf16*)(ws + WS_H);
    float* const RS1 = (float*)(ws + WS_CTL) + CW_RS1; float* const SS2 = (float*)(ws + WS_CTL) + CW_SS2; float* const SS3 = (float*)(ws + WS_CTL) + CW_SS3; float* const SS4 = (float*)(ws + WS_CTL) + CW_SS4;
    for (int u = tid; u < (LDS_BYTES - LDSCTL_OFF) / 4; u += NWAVES * 64) ((LAS unsigned*)(L + LDSCTL_OFF))[u] = 0u;
    __syncthreads();
    const int lo = args.ph_lo, hi = args.ph_hi;
    const bool use_bar = (hi - lo) > 1;
    XcdBarrier bar; bar.bar = (unsigned*)(ctl + CW_BAR) + args.li * XCD_BAR_WORDS; bar.x = 0; bar.st = nullptr;
    if (use_bar) bar = xcd_barrier_post((unsigned*)(ctl + CW_BAR) + args.li * XCD_BAR_WORDS, MISC + 8);
#define IN(k) (lo <= (k) && (k) < hi)
#define SEAM(k) do { if (IN(k) && IN((k) + 1)) xcd_barrier(bar); } while (0)
    const int gw = vcu * NWAVES + wave, NGW = G * NWAVES;

    if (IN(0)) for (int rep_ = 0; rep_ < ((REP_PHASE == 0) ? 2 : 1); ++rep_) {
        constexpr int I_GU = (D / 64) * (2 * FF / 64), I_DN = (FF / 64) * (D / 64), I_IN = (D / 64) * (NIN / 64), I_BR = (1024 / 64) * (D / 64), I_OUT = (D / 64) * (D / 64);
        constexpr int NITEMS = 2 * I_GU + 2 * I_DN + I_IN + 2 * I_BR + I_OUT;
        for (int it = gw; it < NITEMS; it += NGW) {
            int r = it;
            if (r < I_GU) { p0_convert_item<true>(args.in[3], D, 2 * FF, args.in[2], (bf16*)(ws + WS_WGU1), r, lane); continue; } r -= I_GU;
            if (r < I_GU) { p0_convert_item<true>(args.in[16], D, 2 * FF, args.in[15], (bf16*)(ws + WS_WGU2), r, lane); continue; } r -= I_GU;
            if (r < I_DN) { p0_convert_item<false>(args.in[4], FF, D, nullptr, (bf16*)(ws + WS_WD1), r, lane); continue; } r -= I_DN;
            if (r < I_DN) { p0_convert_item<false>(args.in[17], FF, D, nullptr, (bf16*)(ws + WS_WD2), r, lane); continue; } r -= I_DN;
            if (r < I_IN) { p0_convert_item<false>(args.in[6], D, NIN, args.in[5], (bf16*)(ws + WS_WIN), r, lane); continue; } r -= I_IN;
            if (r < I_BR) { p0_convert_item<false>(args.in[12], 1024, D, nullptr, (bf16*)(ws + WS_WA), r, lane); continue; } r -= I_BR;
            if (r < I_BR) { p0_convert_item<false>(args.in[13], 1024, D, nullptr, (bf16*)(ws + WS_WB), r, lane); continue; } r -= I_BR;
            p0_convert_item<false>(args.in[14], D, D, nullptr, (bf16*)(ws + WS_WOUT), r, lane);
        }
        for (int m = gw; m < M; m += NGW) {
            const GAS f32x4* xr = (const GAS f32x4*)(x + (size_t)m * D) + lane;
            f32x4 v[8]; float s = 0.f;
#pragma unroll
            for (int j = 0; j < 8; ++j) { v[j] = xr[64 * j]; s += (v[j].x * v[j].x + v[j].y * v[j].y) + (v[j].z * v[j].z + v[j].w * v[j].w); }
            s = wave_sum(s);
            if (lane == 0) RS1[m] = rsqrtf(s * (1.0f / D) + 1e-6f);
            GAS unsigned long long* o8 = (GAS unsigned long long*)(XB + (size_t)m * D) + lane;
#pragma unroll
            for (int j = 0; j < 8; ++j) o8[64 * j] = (unsigned long long)cvtpk(v[j].x, v[j].y) | ((unsigned long long)cvtpk(v[j].z, v[j].w) << 32);
        }
    }
    SEAM(0);
    if (IN(1)) for (int rep_ = 0; rep_ < ((REP_PHASE == 1) ? 2 : 1); ++rep_) {
        pg8::Gemm g{XB, (const bf16*)(ws + WS_WGU1), M, 2 * FF, D}; pg8::StaticOrder S; S.init(M, 2 * FF, G, bx);
        pg8::EpiSwiGLU<false> E{HB, RS1};
        pg8::gemm_phase<pg8::EpiSwiGLU<false>, pg8::StaticOrder, PG8_ALIGN, PG8_SP2>(L + RING_OFF, g, S, E);
    }
    SEAM(1);
    if (IN(2)) {
        pg8::Gemm g{HB, (const bf16*)(ws + WS_WD1), M, D, FF}; pg8::StaticOrder S; S.init(M, D, G, bx);
        pg8::EpiResid<true> E{x, out, XB, SS2, 0.5f};
        pg8::gemm_phase<pg8::EpiResid<true>, pg8::StaticOrder, PG8_ALIGN, PG8_SP2>(L + RING_OFF, g, S, E);
    }
    SEAM(2);
    if (IN(3)) {
        pg8::Gemm g{XB, (const bf16*)(ws + WS_WIN), M, 6144, D}; pg8::StaticOrder S; S.init(M, 6144, G, bx);
        pg8::EpiQKV E{(bf16*)(ws + WS_QKV), QKV_SPLIT / 2, SS2, C2};
        pg8::gemm_phase<pg8::EpiQKV, pg8::StaticOrder, PG8_ALIGN, PG8_SP2>(L + RING_OFF, g, S, E);
    }
    SEAM(3);
    if (IN(4)) for (int rep_ = 0; rep_ < ((REP_PHASE == 4) ? 2 : 1); ++rep_) {
        const bf16* q6 = (const bf16*)(ws + WS_QKV); const size_t sp = QKV_SPLIT / 2;
#ifndef ATT_NAIVE_DA
        {   const float lam = __expf(wave_sum(args.in[7][lane] * args.in[8][lane])) - __expf(wave_sum(args.in[9][lane] * args.in[10][lane])) + LAMBDA_INIT;
            LAS float* TB = (LAS float*)(L + LDSCTL_OFF + 1024); LAS float* wsf = (LAS float*)(L + LDSCTL_OFF + 4096);
            const int bh = vcu >> 3, s8 = vcu & 7;
            for (int i = 0; i < 2; ++i)
                att::da_unit(bh / DA_HEADS, bh % DA_HEADS, i == 0 ? 15 - s8 : s8, q6, q6 + sp, q6 + 2 * sp, (bf16*)(ws + WS_OA), L + RING_OFF, TB, wsf, args.in[1], args.in[11], lam);
        }
#endif
#ifndef ATT_NAIVE_SB
        {   const int bh = vcu >> 2, s4 = vcu & 3;
            for (int i = 0; i < 2; ++i)
                att::sb_unit(bh / SB_HEADS, bh % SB_HEADS, i == 0 ? 7 - s4 : s4, q6 + 3 * sp, q6 + 4 * sp, q6 + 5 * sp, (bf16*)(ws + WS_OB), L + RING_OFF);
        }
#endif
#if defined(ATT_NAIVE_DA) || defined(ATT_NAIVE_SB)
        {   LAS float* sS = (LAS float*)(L + RING_OFF) + wave * (2 * SEQ); LAS float* sQ = (LAS float*)(L + LDSCTL_OFF + 1024) + wave * 128;
            __syncthreads();
#ifdef ATT_NAIVE_DA
            const float lam = __expf(wave_sum(args.in[7][lane] * args.in[8][lane])) - __expf(wave_sum(args.in[9][lane] * args.in[10][lane])) + LAMBDA_INIT;
            for (int i = 0; i < BATCH * DA_HEADS; ++i) { const int q = (gw + 65 * i) & (SEQ - 1);
                da_row_naive(sS, sQ, i / DA_HEADS, i % DA_HEADS, q, lane, lam, q6, q6 + sp, q6 + 2 * sp, args.in[1], args.in[11], (bf16*)(ws + WS_OA)); }
#endif
#ifdef ATT_NAIVE_SB
            for (int i = 0; i < BATCH * SB_HEADS; ++i) { const int q = (gw + 65 * i) & (SEQ - 1);
                sb_row_naive(sS, sQ, i / SB_HEADS, i % SB_HEADS, q, lane, q6 + 3 * sp, q6 + 4 * sp, q6 + 5 * sp, (bf16*)(ws + WS_OB)); }
#endif
            __syncthreads();
        }
#endif
    }
    SEAM(4);
    if (IN(5)) {
        bf16* const Gt = (bf16*)(ws + WS_G); float* const T = (float*)(ws + WS_T); bf16* const MG = (bf16*)(ws + WS_MG);
        pg8::StaticOrder S; S.init(M, D, G, bx);
        { pg8::Gemm g{XB, (const bf16*)(ws + WS_WIN) + (size_t)6144 * D, M, D, D}; pg8::EpiGate E{Gt, SS2};
          pg8::gemm_phase<pg8::EpiGate, pg8::StaticOrder, PG8_ALIGN, PG8_SP2>(L + RING_OFF, g, S, E); }
        { pg8::Gemm g{(const bf16*)(ws + WS_OA), (const bf16*)(ws + WS_WA), M, D, 1024}; pg8::EpiBranch<true> E{Gt, T, MG};
          pg8::gemm_phase<pg8::EpiBranch<true>, pg8::StaticOrder, PG8_ALIGN, PG8_SP2>(L + RING_OFF, g, S, E); }
        { pg8::Gemm g{XB, (const bf16*)(ws + WS_WIN) + (size_t)8192 * D, M, D, D}; pg8::EpiGate E{Gt, SS2};
          pg8::gemm_phase<pg8::EpiGate, pg8::StaticOrder, PG8_ALIGN, PG8_SP2>(L + RING_OFF, g, S, E); }
        { pg8::Gemm g{(const bf16*)(ws + WS_OB), (const bf16*)(ws + WS_WB), M, D, 1024}; pg8::EpiBranch<false> E{Gt, T, MG};
          pg8::gemm_phase<pg8::EpiBranch<false>, pg8::StaticOrder, PG8_ALIGN, PG8_SP2>(L + RING_OFF, g, S, E); }
    }
    SEAM(5);
    if (IN(6)) {
        pg8::Gemm g{(const bf16*)(ws + WS_MG), (const bf16*)(ws + WS_WOUT), M, D, D}; pg8::StaticOrder S; S.init(M, D, G, bx);
        pg8::EpiResid<true> E{out, out, XB, SS3, 1.0f};
        pg8::gemm_phase<pg8::EpiResid<true>, pg8::StaticOrder, PG8_ALIGN, PG8_SP2>(L + RING_OFF, g, S, E);
    }
    SEAM(6);
    if (IN(7)) for (int rep_ = 0; rep_ < ((REP_PHASE == 7) ? 2 : 1); ++rep_) {
        pg8::Gemm g{XB, (const bf16*)(ws + WS_WGU2), M, 2 * FF, D}; pg8::StaticOrder S; S.init(M, 2 * FF, G, bx);
        pg8::EpiSwiGLU<true> E{HB, SS3};
        pg8::gemm_phase<pg8::EpiSwiGLU<true>, pg8::StaticOrder, PG8_ALIGN, PG8_SP2>(L + RING_OFF, g, S, E);
    }
    SEAM(7);
    if (IN(8)) {
        pg8::Gemm g{HB, (const bf16*)(ws + WS_WD2), M, D, FF}; pg8::StaticOrder S; S.init(M, D, G, bx);
        pg8::EpiResid<false> E{out, out, nullptr, SS4, 0.5f};
        pg8::gemm_phase<pg8::EpiResid<false>, pg8::StaticOrder, PG8_ALIGN, PG8_SP2>(L + RING_OFF, g, S, E);
    }
    SEAM(8);
    if (IN(9)) {
        const float* gf = args.in[18];
        for (int m = gw; m < M; m += NGW) {
            GAS f32x4* xr = (GAS f32x4*)(out + (size_t)m * D) + lane; const GAS f32x4* gr = (const GAS f32x4*)gf + lane;
            const float r = rsqrtf(SS4[m] * (1.0f / D) + 1e-6f);
#pragma unroll
            for (int j = 0; j < 8; ++j) { const f32x4 v = xr[64 * j]; xr[64 * j] = v * r * gr[64 * j]; }
        }
    }
#undef IN
#undef SEAM
}

extern "C" void kernel_launch(void* const* d_in, const int* in_sizes, int n_in, void* d_out, int out_size, void* d_ws, size_t ws_size, hipStream_t stream) {
    static int grid = 0;
    if (grid == 0) {
        if (n_in != 19 || out_size != M * D || ws_size < WS_END) { fprintf(stderr, "kernel_launch: unexpected shapes (n_in %d out %d ws %zu)\n", n_in, out_size, ws_size); grid = -1; return; }
        int dev = 0, cus = 0, per_cu = 0;
        if (hipGetDevice(&dev) != hipSuccess || hipDeviceGetAttribute(&cus, hipDeviceAttributeMultiprocessorCount, dev) != hipSuccess) { grid = -1; return; }
        if (hipFuncSetAttribute((const void*)mega_fwd, hipFuncAttributeMaxDynamicSharedMemorySize, LDS_BYTES) != hipSuccess) { fprintf(stderr, "kernel_launch: hipFuncSetAttribute failed\n"); grid = -1; return; }
        if (hipOccupancyMaxActiveBlocksPerMultiprocessor(&per_cu, (const void*)mega_fwd, NWAVES * 64, LDS_BYTES) != hipSuccess || per_cu < 1) fprintf(stderr, "kernel_launch: occupancy query says %d\n", per_cu);
        (void)hipGetLastError();
        grid = cus;
    }
    if (grid < 0) return;
    (void)hipMemsetAsync((char*)d_ws + WS_CTL, 0, CTL_ZERO_BYTES, stream);
    Args a{};
    for (int i = 0; i < 19; ++i) a.in[i] = (const float*)d_in[i];
    a.out = (float*)d_out; a.ws = (unsigned char*)d_ws;
    unsigned char* ws = (unsigned char*)d_ws;
    auto mega = [&](int lo, int hi, int li) { a.ph_lo = lo; a.ph_hi = hi; a.li = li; hipLaunchKernelGGL(mega_fwd, dim3(grid), dim3(NWAVES * 64), LDS_BYTES, stream, a); };
    auto naive_attn = [&]() {
        const bf16* q6 = (const bf16*)(ws + WS_QKV); const size_t sp = QKV_SPLIT / 2;
        k_da_naive<<<BATCH * DA_HEADS * SEQ / 2, 128, 0, stream>>>(q6, q6 + sp, q6 + 2 * sp, a.in[1], a.in[7], a.in[8], a.in[9], a.in[10], a.in[11], (bf16*)(ws + WS_OA));
        k_sb_naive<<<BATCH * SB_HEADS * SEQ / 4, 256, 0, stream>>>(q6 + 3 * sp, q6 + 4 * sp, q6 + 5 * sp, (bf16*)(ws + WS_OB));
    };
#if MK_MODE == 0
    for (int p = 0; p < N_PHASES; ++p) { if (p == 4) naive_attn(); else mega(p, p + 1, 0); }
#elif MK_MODE == 1
    mega(0, 4, 0); naive_attn(); mega(5, N_PHASES, 1);
#else
    mega(0, N_PHASES, 0);
#endif
}
```

```cpp
#include <hip/hip_runtime.h>
#include <cstdio>
#include <cstdint>
#include <math.h>

namespace pg8 {
#define PG8_LAS __attribute__((address_space(3)))
typedef unsigned short bf16_t;
typedef short bf16x8 __attribute__((ext_vector_type(8)));
typedef float f32x4 __attribute__((ext_vector_type(4)));
typedef unsigned u32x4 __attribute__((ext_vector_type(4)));
constexpr int BM = 256, BK = 64, HALF = 128, HTB = HALF * BK * 2  , STAGE_BYTES = 8 * HTB, NXCD = 8, WGM = 8;

__host__ __device__ __forceinline__ int lds_byte(int r, int c) { const int st = (r >> 4) * 2 + (c >> 5), rr = r & 15, cc = c & 31, ob = rr * 64 + cc * 2; return st * 1024 + (ob ^ (((ob >> 9) & 1) << 5)); }
__host__ __device__ __forceinline__ void stage_rc(int b, int& R, int& C) { const int st = b / 1024, sb = b % 1024, swz = sb ^ (((sb >> 9) & 1) << 5); R = (st >> 1) * 16 + swz / 64; C = (st & 1) * 32 + (swz % 64) / 2; }
__host__ __device__ __forceinline__ int perm32(int rho) { const int n = rho >> 4, i = rho & 15; return 8 * (i >> 2) + 4 * n + (i & 3); }

struct Unit { int pm, pn; };
struct Gemm { const bf16_t* A; const bf16_t* Bt; int M, N, K; };

struct StaticOrder {
    int nM, nN, nwg, G, c;
    __host__ __device__ void init(int M, int N, int G_, int c_) { nM = M / BM; nN = N / BM; nwg = nM * nN; G = G_; c = c_; }
    __host__ __device__ bool next(int i, Unit& u) const {
        const long L = (long)i * G + c; if (L >= nwg) return false;
        int wgid = (int)L; { const int q = nwg / NXCD, r = nwg % NXCD, xcd = wgid % NXCD, off = wgid / NXCD; wgid = (xcd < r ? xcd * (q + 1) : r * (q + 1) + (xcd - r) * q) + off; }
        const int nig = WGM * nN, gid = wgid / nig, fm = gid * WGM, gsz = (nM - fm) < WGM ? (nM - fm) : WGM;
        u.pm = fm + ((wgid % nig) % gsz); u.pn = (wgid % nig) / gsz; return true;
    }
    __device__ __forceinline__ void a_ready(const Unit&) const {}
    __device__ __forceinline__ void done(const Unit&) const {}
};
__device__ __forceinline__ unsigned cvt_pk_bf16(float lo, float hi) { unsigned r; asm volatile("v_cvt_pk_bf16_f32 %0, %1, %2" : "=v"(r) : "v"(lo), "v"(hi)); return r; }
typedef float f32x2 __attribute__((ext_vector_type(2)));
constexpr float RMS_EPS = 1e-6f, LOG2E = 1.4426950408889634f;
__device__ __forceinline__ float rstd_of(float ss) { return rsqrtf(ss * (1.0f / 2048.0f) + RMS_EPS); }
__device__ __forceinline__ float sigm(float g) { return __builtin_amdgcn_rcpf(1.0f + __builtin_amdgcn_exp2f(-LOG2E * g)); }
__device__ __forceinline__ u32x4 pack8(const f32x4& a, const f32x4& b) { u32x4 w; w.x = cvt_pk_bf16(a[0], a[1]); w.y = cvt_pk_bf16(a[2], a[3]); w.z = cvt_pk_bf16(b[0], b[1]); w.w = cvt_pk_bf16(b[2], b[3]); return w; }
__device__ __forceinline__ float bflo(unsigned w) { return __uint_as_float(w << 16); }
__device__ __forceinline__ float bfhi(unsigned w) { return __uint_as_float(w & 0xffff0000u); }
template <bool SSQ> struct EpiSwiGLU {
    static constexpr bool PERM = true, AFTER_DRAIN = false;
    bf16_t* H; const float* rs;
    __device__ __forceinline__ void operator()(const f32x4 (&acc)[2][2][4][2], const Unit& u, int wr, int wc, int fr, int fq) const {
        const int row0 = u.pm * BM + wr * 64 + fr, col0 = u.pn * 128 + wc * 32 + 8 * fq;
#pragma unroll
        for (int ai = 0; ai < 2; ++ai)
#pragma unroll
            for (int m = 0; m < 4; ++m) {
                const int row = row0 + ai * HALF + m * 16;
                float r = rs[row]; if (SSQ) r = rstd_of(r);
                f32x4 h0, h1;
#pragma unroll
                for (int e = 0; e < 4; ++e) {
                    const float g0 = acc[ai][0][m][0][e] * r, g1 = acc[ai][0][m][1][e] * r;
                    h0[e] = g0 * sigm(g0) * (acc[ai][1][m][0][e] * r); h1[e] = g1 * sigm(g1) * (acc[ai][1][m][1][e] * r);
                }
                *(u32x4*)(H + (size_t)row * 5632 + col0) = pack8(h0, h1);
            }
    }
};
template <bool IN_BF16, bool OUT_F32, bool OUT_BF16> struct EpiResid {
    static constexpr bool PERM = true, AFTER_DRAIN = false;
    const float* xin; const bf16_t* xinb; float* xout; bf16_t* xb; float* ss; float alpha;
    __device__ __forceinline__ void operator()(const f32x4 (&acc)[2][2][4][2], const Unit& u, int wr, int wc, int fr, int fq) const {
        const int row0 = u.pm * BM + wr * 64 + fr, col0 = u.pn * BM + wc * 32 + 8 * fq;
#pragma unroll
        for (int ai = 0; ai < 2; ++ai)
#pragma unroll
            for (int m = 0; m < 4; ++m) {
                const int row = row0 + ai * HALF + m * 16; const size_t off = (size_t)row * 2048 + col0; float sq = 0.f;
#pragma unroll
                for (int bj = 0; bj < 2; ++bj) {
                    f32x4 a0, a1;
                    if (IN_BF16) { const u32x4 w = *(const u32x4*)(xinb + off + bj * HALF);
                        a0 = (f32x4){bflo(w.x), bfhi(w.x), bflo(w.y), bfhi(w.y)}; a1 = (f32x4){bflo(w.z), bfhi(w.z), bflo(w.w), bfhi(w.w)}; }
                    else { a0 = *(const f32x4*)(xin + off + bj * HALF); a1 = *(const f32x4*)(xin + off + bj * HALF + 4); }
                    const f32x4 o0 = a0 + acc[ai][bj][m][0] * alpha, o1 = a1 + acc[ai][bj][m][1] * alpha;
                    if (OUT_F32) { *(f32x4*)(xout + off + bj * HALF) = o0; *(f32x4*)(xout + off + bj * HALF + 4) = o1; }
                    sq += (o0[0] * o0[0] + o0[1] * o0[1]) + (o0[2] * o0[2] + o0[3] * o0[3]) + (o1[0] * o1[0] + o1[1] * o1[1]) + (o1[2] * o1[2] + o1[3] * o1[3]);
                    if (OUT_BF16) *(u32x4*)(xb + off + bj * HALF) = pack8(o0, o1);
                }
                sq += __shfl_xor(sq, 16); sq += __shfl_xor(sq, 32);
                if (fq == 0) atomicAdd(ss + row, sq);
                if (m & 1) asm volatile("" ::: "memory");
            }
    }
};
struct EpiQKV {
    static constexpr bool PERM = true, AFTER_DRAIN = false;
    bf16_t* base; size_t split; const float* ss; float qscale;
    __device__ __forceinline__ void operator()(const f32x4 (&acc)[2][2][4][2], const Unit& u, int wr, int wc, int fr, int fq) const {
        const int row0 = u.pm * BM + wr * 64 + fr; int colt = u.pn * BM; const int t = colt / 1024; colt -= t * 1024;
        bf16_t* ob = base + (size_t)t * split; const float sc = (t == 0 || t == 3) ? qscale : 1.0f; const int col0 = colt + wc * 32 + 8 * fq;
#pragma unroll
        for (int ai = 0; ai < 2; ++ai)
#pragma unroll
            for (int m = 0; m < 4; ++m) {
                const int row = row0 + ai * HALF + m * 16; const float r = rstd_of(ss[row]) * sc;
#pragma unroll
                for (int bj = 0; bj < 2; ++bj) *(u32x4*)(ob + (size_t)row * 1024 + col0 + bj * HALF) = pack8(acc[ai][bj][m][0] * r, acc[ai][bj][m][1] * r);
            }
    }
};
struct EpiGate {
    static constexpr bool PERM = true, AFTER_DRAIN = false;
    bf16_t* G; const float* ss;
    __device__ __forceinline__ void operator()(const f32x4 (&acc)[2][2][4][2], const Unit& u, int wr, int wc, int fr, int fq) const {
        const int row0 = u.pm * BM + wr * 64 + fr, col0 = u.pn * BM + wc * 32 + 8 * fq;
#pragma unroll
        for (int ai = 0; ai < 2; ++ai)
#pragma unroll
            for (int m = 0; m < 4; ++m) {
                const int row = row0 + ai * HALF + m * 16; const float r = rstd_of(ss[row]);
#pragma unroll
                for (int bj = 0; bj < 2; ++bj) { f32x4 s0, s1;
#pragma unroll
                    for (int e = 0; e < 4; ++e) { s0[e] = sigm(acc[ai][bj][m][0][e] * r); s1[e] = sigm(acc[ai][bj][m][1][e] * r); }
                    *(u32x4*)(G + (size_t)row * 2048 + col0 + bj * HALF) = pack8(s0, s1); }
            }
    }
};
template <bool FIRST> struct EpiBranch {
    static constexpr bool PERM = true, AFTER_DRAIN = false;
    const bf16_t* G; bf16_t* T; bf16_t* MG;
    __device__ __forceinline__ void operator()(const f32x4 (&acc)[2][2][4][2], const Unit& u, int wr, int wc, int fr, int fq) const {
        const int row0 = u.pm * BM + wr * 64 + fr, col0 = u.pn * BM + wc * 32 + 8 * fq;
#pragma unroll
        for (int ai = 0; ai < 2; ++ai)
#pragma unroll
            for (int m = 0; m < 4; ++m) {
                const int row = row0 + ai * HALF + m * 16;
#pragma unroll
                for (int bj = 0; bj < 2; ++bj) { const size_t off = (size_t)row * 2048 + col0 + bj * HALF;
                    const u32x4 g = *(const u32x4*)(G + off);
                    f32x4 o0, o1;
                    o0[0] = bflo(g.x) * acc[ai][bj][m][0][0]; o0[1] = bfhi(g.x) * acc[ai][bj][m][0][1]; o0[2] = bflo(g.y) * acc[ai][bj][m][0][2]; o0[3] = bfhi(g.y) * acc[ai][bj][m][0][3];
                    o1[0] = bflo(g.z) * acc[ai][bj][m][1][0]; o1[1] = bfhi(g.z) * acc[ai][bj][m][1][1]; o1[2] = bflo(g.w) * acc[ai][bj][m][1][2]; o1[3] = bfhi(g.w) * acc[ai][bj][m][1][3];
                    if (FIRST) *(u32x4*)(T + off) = pack8(o0, o1);
                    else { const u32x4 tv = *(const u32x4*)(T + off);
                        o0[0] += bflo(tv.x); o0[1] += bfhi(tv.x); o0[2] += bflo(tv.y); o0[3] += bfhi(tv.y); o1[0] += bflo(tv.z); o1[1] += bfhi(tv.z); o1[2] += bflo(tv.w); o1[3] += bfhi(tv.w);
                        *(u32x4*)(MG + off) = pack8(o0, o1); } }
                if (m & 1) asm volatile("" ::: "memory");
            }
    }
};


template <class Epi, class Sched, bool ALIGN_EPI = false, bool SP2 = false>
__device__ __forceinline__ void gemm_phase(PG8_LAS unsigned char* lds, const Gemm g, const Sched& S, const Epi& E) {
    const int tid = threadIdx.x, wid = __builtin_amdgcn_readfirstlane(tid >> 6), lane = tid & 63, wr = wid >> 2, wc = wid & 3, fr = lane & 15, fq = lane >> 4;
    const int K = g.K, nt = K / BK;
    unsigned voffA[2], voffB[2];
#pragma unroll
    for (int i = 0; i < 2; ++i) { int R, C; stage_rc(tid * 16 + i * 8192, R, C); const int Rb = Epi::PERM ? ((R & ~31) + perm32(R & 31)) : R;
        voffA[i] = (unsigned)(R * K + C) * 2u; voffB[i] = (unsigned)(Rb * K + C) * 2u; }
    const size_t kstep = (size_t)(BK * 2);
    const size_t hstep = (size_t)HALF * K * 2;
    const size_t tstep = 2 * hstep;
    const unsigned ldsw = (unsigned)wid * 1024u;
    const int aoff = lds_byte(wr * 64 + fr, fq * 8), boff = lds_byte(wc * 32 + fr, fq * 8);
#define PG8_SA(b, h) (((b) * 2 + (h)) * HTB)
#define PG8_SB(b, h) ((4 + (b) * 2 + (h)) * HTB)
#define PG8_STAGE(bufoff, gbase, voff) do { _Pragma("unroll") for (int _i = 0; _i < 2; ++_i) \
        __builtin_amdgcn_global_load_lds((const unsigned*)((const char*)(gbase) + (voff)[_i]), (PG8_LAS unsigned*)(lds + (bufoff) + ldsw + _i * 8192), 16, 0, 0); } while (0)
#define PG8_LDA(dst, b, h) do { _Pragma("unroll") for (int m = 0; m < 4; ++m) _Pragma("unroll") for (int k = 0; k < 2; ++k) dst[m][k] = *(const PG8_LAS bf16x8*)(lds + PG8_SA(b, h) + aoff + m * 2048 + k * 1024); } while (0)
#define PG8_LDB(dst, b, h) do { _Pragma("unroll") for (int n = 0; n < 2; ++n) _Pragma("unroll") for (int k = 0; k < 2; ++k) dst[n][k] = *(const PG8_LAS bf16x8*)(lds + PG8_SB(b, h) + boff + n * 2048 + k * 1024); } while (0)
#define PG8_MMA(ai, bj, At, Bt) do { __builtin_amdgcn_s_setprio(1); _Pragma("unroll") for (int m = 0; m < 4; ++m) _Pragma("unroll") for (int n = 0; n < 2; ++n) _Pragma("unroll") for (int k = 0; k < 2; ++k) \
        acc[ai][bj][m][n] = __builtin_amdgcn_mfma_f32_16x16x32_bf16(Bt[n][k], At[m][k], acc[ai][bj][m][n], 0, 0, 0); __builtin_amdgcn_s_setprio(0); } while (0)
#define PG8_WAIT_V(n) asm volatile("s_waitcnt vmcnt(" #n ")" ::: "memory")
#define PG8_WAIT_L(n) asm volatile("s_waitcnt lgkmcnt(" #n ")" ::: "memory")
#define PG8_BAR __builtin_amdgcn_s_barrier()
#define PG8_SCHED __builtin_amdgcn_sched_barrier(0)
    Unit cur, nxt; int ui = 0;
    if (!S.next(0, cur)) return;
    f32x4 acc[2][2][4][2];
#pragma unroll
    for (int a = 0; a < 2; ++a)
#pragma unroll
        for (int b = 0; b < 2; ++b)
#pragma unroll
            for (int m = 0; m < 4; ++m)
#pragma unroll
                for (int n = 0; n < 2; ++n) acc[a][b][m][n] = (f32x4){0.f, 0.f, 0.f, 0.f};
    bf16x8 At[4][2], B0[2][2], B1[2][2];
    const char* cA = (const char*)g.A + (size_t)cur.pm * tstep; const char* cB = (const char*)g.Bt + (size_t)cur.pn * tstep;
    S.a_ready(cur);
    if constexpr (SP2) {
        PG8_STAGE(PG8_SB(0, 0), cB, voffB); PG8_STAGE(PG8_SB(0, 1), cB + hstep, voffB); PG8_STAGE(PG8_SA(0, 0), cA, voffA); PG8_STAGE(PG8_SA(0, 1), cA + hstep, voffA);
        if (wr == 1) PG8_BAR;
        PG8_WAIT_V(2); PG8_BAR;
        PG8_STAGE(PG8_SB(1, 0), cB + kstep, voffB); PG8_STAGE(PG8_SA(1, 0), cA + kstep, voffA); PG8_STAGE(PG8_SB(1, 1), cB + hstep + kstep, voffB);
        PG8_WAIT_V(6); PG8_BAR;
    } else {
        PG8_STAGE(PG8_SB(0, 0), cB, voffB); PG8_STAGE(PG8_SA(0, 0), cA, voffA); PG8_STAGE(PG8_SB(0, 1), cB + hstep, voffB); PG8_STAGE(PG8_SA(0, 1), cA + hstep, voffA);
        if (wr == 1) PG8_BAR;
        PG8_WAIT_V(4); PG8_BAR;
        PG8_STAGE(PG8_SB(1, 0), cB + kstep, voffB); PG8_STAGE(PG8_SA(1, 0), cA + kstep, voffA); PG8_STAGE(PG8_SB(1, 1), cB + hstep + kstep, voffB);
        PG8_WAIT_V(6); PG8_BAR;
    }
    for (;;) {
        const bool has_next = S.next(ui + 1, nxt);
        const char* nA = has_next ? (const char*)g.A + (size_t)nxt.pm * tstep : cA; const char* nB = has_next ? (const char*)g.Bt + (size_t)nxt.pn * tstep : cB;
        for (int t = 0; t < nt; t += 2) {
            const bool last = (t == nt - 2);
            const char* a1 = cA + (size_t)(t + 1) * kstep;
            const char* a2 = last ? nA : cA + (size_t)(t + 2) * kstep; const char* b2 = last ? nB : cB + (size_t)(t + 2) * kstep;
            const char* a3 = a2 + kstep; const char* b3 = b2 + kstep;
            if (last && has_next) S.a_ready(nxt);
            if constexpr (SP2) {
            PG8_LDB(B0, 0, 0); PG8_LDB(B1, 0, 1); PG8_SCHED; PG8_LDA(At, 0, 0); PG8_STAGE(PG8_SA(1, 1), a1 + hstep, voffA);
            PG8_WAIT_V(8); PG8_WAIT_L(0); PG8_BAR; PG8_MMA(0, 0, At, B0); PG8_MMA(0, 1, At, B1); PG8_BAR; PG8_SCHED;
            PG8_LDA(At, 0, 1); PG8_STAGE(PG8_SB(0, 0), b2, voffB); PG8_STAGE(PG8_SB(0, 1), b2 + hstep, voffB); PG8_STAGE(PG8_SA(0, 0), a2, voffA);
            PG8_WAIT_V(8); PG8_WAIT_L(0); PG8_BAR; PG8_MMA(1, 0, At, B0); PG8_MMA(1, 1, At, B1); PG8_BAR; PG8_SCHED;
            PG8_LDB(B0, 1, 0); PG8_LDB(B1, 1, 1); PG8_SCHED; PG8_LDA(At, 1, 0); PG8_STAGE(PG8_SA(0, 1), a2 + hstep, voffA);
            PG8_WAIT_V(8); PG8_WAIT_L(0); PG8_BAR; PG8_MMA(0, 0, At, B0); PG8_MMA(0, 1, At, B1); PG8_BAR; PG8_SCHED;
            PG8_LDA(At, 1, 1); PG8_STAGE(PG8_SB(1, 0), b3, voffB); PG8_STAGE(PG8_SB(1, 1), b3 + hstep, voffB); PG8_STAGE(PG8_SA(1, 0), a3, voffA);
            PG8_WAIT_V(8); PG8_WAIT_L(0); PG8_BAR; PG8_MMA(1, 0, At, B0); PG8_MMA(1, 1, At, B1); PG8_BAR; PG8_SCHED;
            } else {
            PG8_LDB(B0, 0, 0); PG8_SCHED; PG8_LDA(At, 0, 0); PG8_STAGE(PG8_SA(1, 1), a1 + hstep, voffA);
            PG8_WAIT_L(8); PG8_BAR; PG8_WAIT_L(0); PG8_MMA(0, 0, At, B0); PG8_BAR; PG8_SCHED;
            PG8_LDB(B1, 0, 1); PG8_STAGE(PG8_SB(0, 0), b2, voffB);
            PG8_BAR; PG8_WAIT_L(0); PG8_MMA(0, 1, At, B1); PG8_BAR;
            PG8_LDA(At, 0, 1); PG8_STAGE(PG8_SA(0, 0), a2, voffA);
            PG8_BAR; PG8_WAIT_L(0); PG8_MMA(1, 0, At, B0); PG8_BAR; PG8_SCHED;
            PG8_STAGE(PG8_SB(0, 1), b2 + hstep, voffB);
            PG8_WAIT_V(6); PG8_BAR; PG8_MMA(1, 1, At, B1); PG8_BAR;
            PG8_LDB(B0, 1, 0); PG8_SCHED; PG8_LDA(At, 1, 0); PG8_STAGE(PG8_SA(0, 1), a2 + hstep, voffA);
            PG8_WAIT_L(8); PG8_BAR; PG8_WAIT_L(0); PG8_MMA(0, 0, At, B0); PG8_BAR; PG8_SCHED;
            PG8_LDB(B1, 1, 1); PG8_STAGE(PG8_SB(1, 0), b3, voffB);
            PG8_BAR; PG8_WAIT_L(0); PG8_MMA(0, 1, At, B1); PG8_BAR;
            PG8_LDA(At, 1, 1); PG8_STAGE(PG8_SA(1, 0), a3, voffA);
            PG8_BAR; PG8_WAIT_L(0); PG8_MMA(1, 0, At, B0); PG8_BAR; PG8_SCHED;
            PG8_STAGE(PG8_SB(1, 1), b3 + hstep, voffB);
            PG8_WAIT_V(6); PG8_BAR; PG8_MMA(1, 1, At, B1); PG8_BAR;
            }
        }
        if constexpr (ALIGN_EPI) { if (wr == 0) PG8_BAR; }
        if constexpr (!Epi::AFTER_DRAIN) { E(acc, cur, wr, wc, fr, fq); S.done(cur); }
        if (!has_next) break;
#pragma unroll
        for (int a = 0; a < 2; ++a)
#pragma unroll
            for (int b = 0; b < 2; ++b)
#pragma unroll
                for (int m = 0; m < 4; ++m)
#pragma unroll
                    for (int n = 0; n < 2; ++n) acc[a][b][m][n] = (f32x4){0.f, 0.f, 0.f, 0.f};
        cur = nxt; cA = nA; cB = nB; ++ui;
        if constexpr (ALIGN_EPI) { if (wr == 1) PG8_BAR; }
    }
    PG8_WAIT_V(0);
    if constexpr (!ALIGN_EPI) { if (wr == 0) PG8_BAR; }
    PG8_BAR;
    if constexpr (Epi::AFTER_DRAIN) { E.fused(acc, cur, wr, wc, fr, fq, lds, wid, lane); S.done(cur); }
#undef PG8_SA
#undef PG8_SB
#undef PG8_STAGE
#undef PG8_LDA
#undef PG8_LDB
#undef PG8_MMA
#undef PG8_WAIT_V
#undef PG8_WAIT_L
#undef PG8_BAR
#undef PG8_SCHED
}
}
#ifndef PG8_SP2
#define PG8_SP2 true
#endif
#ifndef PG8_ALIGN
#define PG8_ALIGN true
#endif
constexpr int NWAVES = 8;
#ifndef REP_PHASE
#define REP_PHASE -1
#endif
#ifndef MK_MODE
#define MK_MODE 2
#endif
constexpr int BATCH = 4, SEQ = 2048, D = 2048, M = BATCH * SEQ, FF = 5632, NIN = 10240;
constexpr int DA_HEADS = 8, SB_HEADS = 16;
constexpr float SUBLN_EPS = 1e-5f, LAMBDA_INIT = 0.2f;
constexpr float C2 = 0.125f * 1.4426950408889634f;
constexpr size_t MiB = 1u << 20;
constexpr size_t WS_CTL = 0, CTL_ZERO_BYTES = 1 * MiB;
constexpr size_t WS_WGU1 = 2 * MiB, WS_WD1 = 46 * MiB, WS_WIN = 68 * MiB, WS_WA = 108 * MiB, WS_WB = 112 * MiB, WS_WOUT = 116 * MiB, WS_WGU2 = 124 * MiB, WS_WD2 = 168 * MiB;
constexpr size_t WS_XB = 190 * MiB;
constexpr size_t WS_H = 222 * MiB;
constexpr size_t WS_OA = 222 * MiB, WS_OB = 238 * MiB, WS_MG = 254 * MiB;
constexpr size_t WS_QKV = 310 * MiB, QKV_SPLIT = 16 * MiB;
constexpr size_t WS_G = 310 * MiB, WS_T = 342 * MiB;
constexpr size_t WS_END = 406 * MiB;
constexpr int CW_BAR = 4096;
constexpr int CW_SS2 = 32768, CW_SS3 = CW_SS2 + M, CW_SS4 = CW_SS3 + M, CW_RS1 = CW_SS4 + M;
static_assert((CW_RS1 + M) * 4 <= (int)CTL_ZERO_BYTES, "CTL words inside the memset region");
constexpr int RING_OFF = 0, RING_BYTES = 131072;
constexpr int LDSCTL_OFF = RING_BYTES, MISC_OFF = LDSCTL_OFF + 320;
constexpr int LDS_BYTES = 147456;

#define GAS __attribute__((address_space(1)))
#define LAS __attribute__((address_space(3)))
typedef unsigned short bf16;
typedef unsigned v4u __attribute__((ext_vector_type(4)));
typedef float f32x4 __attribute__((ext_vector_type(4)));
typedef short bf16x8 __attribute__((ext_vector_type(8)));
typedef GAS unsigned gu32;
typedef GAS unsigned long long gu64;
#define RLX_AGENT __ATOMIC_RELAXED, __HIP_MEMORY_SCOPE_AGENT
#define LDS_WAIT() asm volatile("s_waitcnt lgkmcnt(0)" ::: "memory")
#define VM_WAIT() asm volatile("s_waitcnt vmcnt(0)" ::: "memory")
__device__ __forceinline__ unsigned long long rt() { return __builtin_amdgcn_s_memrealtime(); }
__device__ __forceinline__ unsigned f2bf(float f) { unsigned u = __builtin_bit_cast(unsigned, f); return (u + 0x7fffu + ((u >> 16) & 1u)) >> 16; }
__device__ __forceinline__ unsigned pk2(float lo, float hi) { return f2bf(lo) | (f2bf(hi) << 16); }
#define XB_TMO      128
#define XB_XCNT(j)  (256  + 64 * (j))
#define XB_XSUB(j)  (1280 + 64 * (j))
#define XB_XGEN(j)  (2304 + 64 * (j))
#define XB_TOP      3328
#define XB_TOPGEN   3392
#define XCD_BAR_WORDS 3456
#define XB_SPIN_CAP (1u << 18)

__device__ __forceinline__ unsigned xb_ld(unsigned* p)              { return __hip_atomic_load(p, __ATOMIC_RELAXED, __HIP_MEMORY_SCOPE_AGENT); }
__device__ __forceinline__ unsigned xb_add(unsigned* p, unsigned v) { return __hip_atomic_fetch_add(p, v, __ATOMIC_RELAXED, __HIP_MEMORY_SCOPE_AGENT); }
__device__ __forceinline__ unsigned xb_xcc_id() { return (unsigned)__builtin_amdgcn_s_getreg((3 << 11) | 20) & 0xFu; }
#define XB_SPIN(cond, bar) do { unsigned _sp = 0; while (cond) { __builtin_amdgcn_s_sleep(1); \
    if ((++_sp & 255u) == 0u) { if (xb_ld(&(bar)[XB_TMO])) break; if (_sp > XB_SPIN_CAP) { atomicAdd(&(bar)[XB_TMO], 1u); break; } } } } while (0)

struct XcdBarrier {
    unsigned* bar; unsigned x;
    volatile LAS unsigned* st;
};

__device__ __forceinline__ XcdBarrier xcd_barrier_post(unsigned* bar, volatile LAS unsigned* st) {
    XcdBarrier b; b.bar = bar; b.x = xb_xcc_id(); b.st = st;
    if (threadIdx.x == 0) (void)xb_add(&bar[XB_XCNT(b.x)], 1u);
    return b;
}
__device__ __forceinline__ void xcd_barrier_complete(unsigned* bar, unsigned x, unsigned& nloc, unsigned& nx) {
    const unsigned G = gridDim.x * gridDim.y * gridDim.z;
    unsigned sum, cnt, mine, sp = 0u;
    for (;;) {
        sum = 0u; cnt = 0u; mine = 0u;
#pragma unroll
        for (unsigned j = 0; j < 16; ++j) { const unsigned c = xb_ld(&bar[XB_XCNT(j)]); sum += c; cnt += (c > 0u) ? 1u : 0u; mine = (j == x) ? c : mine; }
        if (sum == G) break;
        __builtin_amdgcn_s_sleep(1);
        if ((++sp & 255u) == 0u) { if (xb_ld(&bar[XB_TMO])) break; if (sp > XB_SPIN_CAP) { atomicAdd(&bar[XB_TMO], 1u); break; } }
    }
    nloc = mine > 0u ? mine : 1u; nx = cnt > 0u ? cnt : 1u;
}

__device__ __forceinline__ void xcd_barrier(const XcdBarrier& b) {
    asm volatile("s_waitcnt vmcnt(0)" ::: "memory");
    __syncthreads();
    if (threadIdx.x == 0) {
        unsigned* bar = b.bar;
        __builtin_amdgcn_s_waitcnt(0);
        unsigned nloc = b.st[0], nx = b.st[1];
        if (nloc == 0u) { xcd_barrier_complete(bar, b.x, nloc, nx); b.st[0] = nloc; b.st[1] = nx; }
        const unsigned old = xb_add(&bar[XB_XSUB(b.x)], 1u);
        const unsigned gen = old / nloc;
        if (old + 1u == (gen + 1u) * nloc) {
            __builtin_amdgcn_fence(__ATOMIC_RELEASE, "agent");
            asm volatile("s_waitcnt vmcnt(0)" ::: "memory");
            const unsigned og = xb_add(&bar[XB_TOP], 1u);
            const unsigned tg = og / nx;
            if (og + 1u == (tg + 1u) * nx) xb_add(&bar[XB_TOPGEN], 1u);
            else XB_SPIN(xb_ld(&bar[XB_TOPGEN]) == tg, bar);
            __builtin_amdgcn_fence(__ATOMIC_ACQUIRE, "agent");
            xb_add(&bar[XB_XGEN(b.x)], 1u);
            asm volatile("s_waitcnt vmcnt(0)" ::: "memory");
        } else {
            XB_SPIN(xb_ld(&bar[XB_XGEN(b.x)]) == gen, bar);
            __builtin_amdgcn_fence(__ATOMIC_ACQUIRE, "agent");
            asm volatile("s_waitcnt vmcnt(0)" ::: "memory");
        }
    }
    __syncthreads();
}
__device__ __forceinline__ float wave_sum(float v) {
#pragma unroll
    for (int o = 1; o < 64; o <<= 1) v += __shfl_xor(v, o);
    return v;
}
__device__ __forceinline__ float wave_max(float v) {
#pragma unroll
    for (int o = 1; o < 64; o <<= 1) v = fmaxf(v, __shfl_xor(v, o));
    return v;
}
typedef float f32x2_t __attribute__((ext_vector_type(2))); typedef __bf16 bf16x2_t __attribute__((ext_vector_type(2)));
__device__ __forceinline__ unsigned cvtpk(float lo, float hi) { f32x2_t v = {lo, hi}; bf16x2_t b = __builtin_convertvector(v, bf16x2_t); return __builtin_bit_cast(unsigned, b); }
template <bool GU>
__device__ __forceinline__ void p0_convert_item(const float* W, int K, int N, const float* gain, bf16* WT, int item, int lane) {
    const int nblk = N / 64, kb = item / nblk, nb = item % nblk, k0 = 64 * kb, n0 = 64 * nb;
    const int a = lane & 15, g = lane >> 4;
    const f32x4* src = (const f32x4*)(W + (size_t)(k0 + 16 * g) * N + n0 + 4 * a);
    f32x4 v[16];
#pragma unroll
    for (int i = 0; i < 16; ++i) v[i] = __builtin_nontemporal_load(src + (size_t)i * (N / 4));
    if (gain) {
        const f32x4* gp = (const f32x4*)(gain + k0 + 16 * g);
#pragma unroll
        for (int j = 0; j < 4; ++j) { const f32x4 gv = gp[j]; v[4 * j] *= gv[0]; v[4 * j + 1] *= gv[1]; v[4 * j + 2] *= gv[2]; v[4 * j + 3] *= gv[3]; }
    }
    int r0 = n0; if (GU) { r0 = (n0 < FF) ? (256 * (n0 / 128) + n0 % 128) : (256 * ((n0 - FF) / 128) + 128 + (n0 - FF) % 128); }
#pragma unroll
    for (int e = 0; e < 4; ++e) {
        v4u o0, o1;
        o0.x = cvtpk(v[0][e], v[1][e]); o0.y = cvtpk(v[2][e], v[3][e]); o0.z = cvtpk(v[4][e], v[5][e]); o0.w = cvtpk(v[6][e], v[7][e]);
        o1.x = cvtpk(v[8][e], v[9][e]); o1.y = cvtpk(v[10][e], v[11][e]); o1.z = cvtpk(v[12][e], v[13][e]); o1.w = cvtpk(v[14][e], v[15][e]);
        v4u* dst = (v4u*)(WT + (size_t)(r0 + 4 * a + e) * K + k0 + 16 * g); dst[0] = o0; dst[1] = o1;
    }
}

__device__ __forceinline__ int rel_bucket(int rel) {
    const int ret = rel > 0 ? 16 : 0; const int n = rel < 0 ? -rel : rel;
    int b;
    if (n < 8) b = n; else if (n < 12) b = 8; else if (n < 16) b = 9; else if (n < 23) b = 10; else if (n < 32) b = 11; else if (n < 46) b = 12; else if (n < 64) b = 13; else if (n < 91) b = 14; else b = 15;
    return ret + b;
}
__device__ __forceinline__ float bf2f(bf16 b) { return __uint_as_float(((unsigned)b) << 16); }
__global__ __launch_bounds__(128) void k_da_naive(const bf16* __restrict__ DQ, const bf16* __restrict__ DK, const bf16* __restrict__ DV, const float* __restrict__ rel_bias,
                                                  const float* lq1, const float* lk1, const float* lq2, const float* lk2, const float* subln, bf16* OA) {
    __shared__ float sS[2][2][SEQ];
    __shared__ float sQ[2][128];
    const int tid = threadIdx.x, w = tid >> 6, lane = tid & 63;
    const int gq = blockIdx.x * 2 + w; const int q = gq % SEQ, bh = gq / SEQ, h = bh % DA_HEADS, b = bh / DA_HEADS;
    const size_t m = (size_t)b * SEQ + q;
    sQ[w][lane] = bf2f(DQ[m * 1024 + h * 128 + lane]); sQ[w][lane + 64] = bf2f(DQ[m * 1024 + h * 128 + 64 + lane]);
    const float lam = __expf(wave_sum(lq1[lane] * lk1[lane])) - __expf(wave_sum(lq2[lane] * lk2[lane])) + LAMBDA_INIT;
    __syncthreads();
    const int nk = (q / 64 + 1) * 64;
    float mx0 = -INFINITY, mx1 = -INFINITY;
    for (int k = lane; k < nk; k += 64) {
        const bf16* kr = DK + ((size_t)b * SEQ + k) * 1024 + h * 128;
        float s0 = 0.f, s1 = 0.f;
#pragma unroll
        for (int c = 0; c < 8; ++c) {
            const uint4 v0 = *(const uint4*)(kr + c * 8), v1 = *(const uint4*)(kr + 64 + c * 8);
            const unsigned a0[4] = {v0.x, v0.y, v0.z, v0.w}, a1[4] = {v1.x, v1.y, v1.z, v1.w};
#pragma unroll
            for (int e = 0; e < 4; ++e) {
                s0 += sQ[w][c * 8 + 2 * e] * __uint_as_float(a0[e] << 16) + sQ[w][c * 8 + 2 * e + 1] * __uint_as_float(a0[e] & 0xffff0000u);
                s1 += sQ[w][64 + c * 8 + 2 * e] * __uint_as_float(a1[e] << 16) + sQ[w][64 + c * 8 + 2 * e + 1] * __uint_as_float(a1[e] & 0xffff0000u);
            }
        }
        const int bk = rel_bucket(k - q);
        s0 = s0 + 1.4426950408889634f * rel_bias[bk * 16 + h * 2 + 0]; s1 = s1 + 1.4426950408889634f * rel_bias[bk * 16 + h * 2 + 1];
        sS[w][0][k] = s0; sS[w][1][k] = s1; mx0 = fmaxf(mx0, s0); mx1 = fmaxf(mx1, s1);
    }
    mx0 = wave_max(mx0); mx1 = wave_max(mx1);
    float l0 = 0.f, l1 = 0.f;
    for (int k = lane; k < nk; k += 64) { const float p0 = exp2f(sS[w][0][k] - mx0), p1 = exp2f(sS[w][1][k] - mx1); sS[w][0][k] = p0; sS[w][1][k] = p1; l0 += p0; l1 += p1; }
    l0 = wave_sum(l0); l1 = wave_sum(l1);
    const float i0 = 1.0f / l0, i1 = lam / l1;
    for (int k = lane; k < nk; k += 64) sS[w][0][k] = sS[w][0][k] * i0 - sS[w][1][k] * i1;
    __syncthreads();
    float o0 = 0.f, o1 = 0.f;
    const bf16* vb = DV + (size_t)b * SEQ * 1024 + h * 128 + 2 * lane;
    for (int k = 0; k < nk; ++k) { const float a = sS[w][0][k]; const unsigned vv = *(const unsigned*)(vb + (size_t)k * 1024); o0 += a * __uint_as_float(vv << 16); o1 += a * __uint_as_float(vv & 0xffff0000u); }
    const float ss = wave_sum(o0 * o0 + o1 * o1);
    const float r = rsqrtf(ss * (1.0f / 128.0f) + SUBLN_EPS) * (1.0f - LAMBDA_INIT);
    *(unsigned*)(OA + m * 1024 + h * 128 + 2 * lane) = pk2(o0 * r * subln[2 * lane], o1 * r * subln[2 * lane + 1]);
}
__global__ __launch_bounds__(256) void k_sb_naive(const bf16* __restrict__ SQ, const bf16* __restrict__ SK, const bf16* __restrict__ SV, bf16* OB) {
    __shared__ float sW[4][SEQ];
    __shared__ float sQ[4][64];
    const int tid = threadIdx.x, w = tid >> 6, lane = tid & 63;
    const int gq = blockIdx.x * 4 + w; const int q = gq % SEQ, bh = gq / SEQ, h = bh % SB_HEADS, b = bh / SB_HEADS;
    const size_t m = (size_t)b * SEQ + q;
    sQ[w][lane] = bf2f(SQ[m * 1024 + h * 64 + lane]);
    __syncthreads();
    const int nchunk = (q + 63) / 64;
    float carry = 0.f;
    for (int c = nchunk - 1; c >= 0; --c) {
        const int j = c * 64 + lane; const bool valid = j < q;
        const bf16* kr = SK + ((size_t)b * SEQ + j) * 1024 + h * 64;
        float z = 0.f;
#pragma unroll
        for (int cc = 0; cc < 8; ++cc) {
            const uint4 v0 = *(const uint4*)(kr + cc * 8); const unsigned a0[4] = {v0.x, v0.y, v0.z, v0.w};
#pragma unroll
            for (int e = 0; e < 4; ++e) z += sQ[w][cc * 8 + 2 * e] * __uint_as_float(a0[e] << 16) + sQ[w][cc * 8 + 2 * e + 1] * __uint_as_float(a0[e] & 0xffff0000u);
        }
        z *= 0.6931471805599453f;
        const float sp = fmaxf(z, 0.f) + log1pf(__expf(-fabsf(z)));
        const float lk = valid ? -sp : 0.f;
        float incl = lk;
#pragma unroll
        for (int off = 1; off < 64; off <<= 1) { const float t = __shfl_down(incl, off); incl += (lane + off < 64) ? t : 0.f; }
        const float lb = carry + incl - lk;
        sW[w][j] = valid ? __expf((z - sp) + lb) : 0.f;
        carry += __shfl(incl, 0);
    }
    __syncthreads();
    float o = 0.f;
    const bf16* vb = SV + (size_t)b * SEQ * 1024 + h * 64 + lane;
    const int nkp = nchunk * 64;
    for (int k = 0; k < nkp; ++k) o += sW[w][k] * bf2f(vb[(size_t)k * 1024]);
    OB[m * 1024 + h * 64 + lane] = (bf16)f2bf(o);
}


__device__ __forceinline__ void da_row_naive(LAS float* sS  , LAS float* sQ  , int b, int h, int q, int lane, float lam, const bf16* __restrict__ DQ, const bf16* __restrict__ DK, const bf16* __restrict__ DV,
                                             const float* __restrict__ rel_bias, const float* subln, bf16* OA) {
    const size_t m = (size_t)b * SEQ + q;
    sQ[lane] = bf2f(DQ[m * 1024 + h * 128 + lane]); sQ[lane + 64] = bf2f(DQ[m * 1024 + h * 128 + 64 + lane]);
    LDS_WAIT(); asm volatile("" ::: "memory");
    const int nk = (q / 64 + 1) * 64;
    float mx0 = -INFINITY, mx1 = -INFINITY;
    for (int k = lane; k < nk; k += 64) {
        const bf16* kr = DK + ((size_t)b * SEQ + k) * 1024 + h * 128;
        float s0 = 0.f, s1 = 0.f;
#pragma unroll
        for (int c = 0; c < 8; ++c) {
            const uint4 v0 = *(const uint4*)(kr + c * 8), v1 = *(const uint4*)(kr + 64 + c * 8);
            const unsigned a0[4] = {v0.x, v0.y, v0.z, v0.w}, a1[4] = {v1.x, v1.y, v1.z, v1.w};
#pragma unroll
            for (int e = 0; e < 4; ++e) {
                s0 += sQ[c * 8 + 2 * e] * __uint_as_float(a0[e] << 16) + sQ[c * 8 + 2 * e + 1] * __uint_as_float(a0[e] & 0xffff0000u);
                s1 += sQ[64 + c * 8 + 2 * e] * __uint_as_float(a1[e] << 16) + sQ[64 + c * 8 + 2 * e + 1] * __uint_as_float(a1[e] & 0xffff0000u);
            }
        }
        const int bk = rel_bucket(k - q);
        s0 = s0 + 1.4426950408889634f * rel_bias[bk * 16 + h * 2 + 0]; s1 = s1 + 1.4426950408889634f * rel_bias[bk * 16 + h * 2 + 1];
        sS[k] = s0; sS[SEQ + k] = s1; mx0 = fmaxf(mx0, s0); mx1 = fmaxf(mx1, s1);
    }
    mx0 = wave_max(mx0); mx1 = wave_max(mx1);
    float l0 = 0.f, l1 = 0.f;
    for (int k = lane; k < nk; k += 64) { const float p0 = exp2f(sS[k] - mx0), p1 = exp2f(sS[SEQ + k] - mx1); sS[k] = p0; sS[SEQ + k] = p1; l0 += p0; l1 += p1; }
    l0 = wave_sum(l0); l1 = wave_sum(l1);
    const float i0 = 1.0f / l0, i1 = lam / l1;
    for (int k = lane; k < nk; k += 64) sS[k] = sS[k] * i0 - sS[SEQ + k] * i1;
    LDS_WAIT(); asm volatile("" ::: "memory");
    float o0 = 0.f, o1 = 0.f;
    const bf16* vb = DV + (size_t)b * SEQ * 1024 + h * 128 + 2 * lane;
    for (int k = 0; k < nk; ++k) { const float a = sS[k]; const unsigned vv = *(const unsigned*)(vb + (size_t)k * 1024); o0 += a * __uint_as_float(vv << 16); o1 += a * __uint_as_float(vv & 0xffff0000u); }
    const float ss = wave_sum(o0 * o0 + o1 * o1);
    const float r = rsqrtf(ss * (1.0f / 128.0f) + SUBLN_EPS) * (1.0f - LAMBDA_INIT);
    *(unsigned*)(OA + m * 1024 + h * 128 + 2 * lane) = pk2(o0 * r * subln[2 * lane], o1 * r * subln[2 * lane + 1]);
    LDS_WAIT(); asm volatile("" ::: "memory");
}
__device__ __forceinline__ void sb_row_naive(LAS float* sW  , LAS float* sQ  , int b, int h, int q, int lane, const bf16* __restrict__ SQ, const bf16* __restrict__ SK, const bf16* __restrict__ SV, bf16* OB) {
    const size_t m = (size_t)b * SEQ + q;
    sQ[lane] = bf2f(SQ[m * 1024 + h * 64 + lane]);
    LDS_WAIT(); asm volatile("" ::: "memory");
    const int nchunk = (q + 63) / 64;
    float carry = 0.f;
    for (int c = nchunk - 1; c >= 0; --c) {
        const int j = c * 64 + lane; const bool valid = j < q;
        const bf16* kr = SK + ((size_t)b * SEQ + j) * 1024 + h * 64;
        float z = 0.f;
#pragma unroll
        for (int cc = 0; cc < 8; ++cc) {
            const uint4 v0 = *(const uint4*)(kr + cc * 8); const unsigned a0[4] = {v0.x, v0.y, v0.z, v0.w};
#pragma unroll
            for (int e = 0; e < 4; ++e) z += sQ[cc * 8 + 2 * e] * __uint_as_float(a0[e] << 16) + sQ[cc * 8 + 2 * e + 1] * __uint_as_float(a0[e] & 0xffff0000u);
        }
        z *= 0.6931471805599453f;
        const float sp = fmaxf(z, 0.f) + log1pf(__expf(-fabsf(z)));
        const float lk = valid ? -sp : 0.f;
        float incl = lk;
#pragma unroll
        for (int off = 1; off < 64; off <<= 1) { const float t = __shfl_down(incl, off); incl += (lane + off < 64) ? t : 0.f; }
        const float lb = carry + incl - lk;
        sW[j] = valid ? __expf((z - sp) + lb) : 0.f;
        carry += __shfl(incl, 0);
    }
    LDS_WAIT(); asm volatile("" ::: "memory");
    float o = 0.f;
    const bf16* vb = SV + (size_t)b * SEQ * 1024 + h * 64 + lane;
    const int nkp = nchunk * 64;
    for (int k = 0; k < nkp; ++k) o += sW[k] * bf2f(vb[(size_t)k * 1024]);
    OB[m * 1024 + h * 64 + lane] = (bf16)f2bf(o);
    LDS_WAIT(); asm volatile("" ::: "memory");
}

namespace att {
typedef __attribute__((ext_vector_type(8))) short bf16x8;
typedef __attribute__((ext_vector_type(4))) short s16x4;
typedef __attribute__((ext_vector_type(16))) float f32x16;
typedef __attribute__((ext_vector_type(4))) unsigned u32x4;
typedef __attribute__((address_space(3))) const char* lds_cptr;
#define ATT_LAS __attribute__((address_space(3)))
#define SBAR() __builtin_amdgcn_sched_barrier(0)
#define WAIT_BAR0() asm volatile("s_waitcnt vmcnt(0) lgkmcnt(0)\n\ts_barrier" ::: "memory")
#define LDS_BAR() asm volatile("s_waitcnt lgkmcnt(0)\n\ts_barrier" ::: "memory")
__device__ __forceinline__ int crowc(int r) { return (r & 3) + 8 * (r >> 2); }
__device__ __forceinline__ void glds16(const void* gsrc, unsigned lds_dst) { unsigned keep;
    asm volatile("s_mov_b32 %0, m0\n\ts_mov_b32 m0, %2\n\ts_nop 0\n\tglobal_load_lds_dwordx4 %1, off\n\ts_mov_b32 m0, %0" : "=&s"(keep) : "v"(gsrc), "s"(lds_dst) : "memory"); }
typedef float f32x2_t __attribute__((ext_vector_type(2))); typedef __bf16 bf16x2_t __attribute__((ext_vector_type(2)));
__device__ __forceinline__ unsigned cvtpk_s(float lo, float hi) { f32x2_t v = {lo, hi}; bf16x2_t b = __builtin_convertvector(v, bf16x2_t); return __builtin_bit_cast(unsigned, b); }
__device__ __forceinline__ void qkt(f32x16& p0, f32x16& p1, lds_cptr Kslot, const bf16x8* qr, const f32x16& cinit, int r32, int hi) {
    lds_cptr kb = Kslot + hi * 1024 + r32 * 16;
#pragma unroll
    for (int d0 = 0; d0 < 4; ++d0) {
        const bf16x8 b0 = *(const ATT_LAS bf16x8*)(kb + d0 * 2048);
        const bf16x8 b1 = *(const ATT_LAS bf16x8*)(kb + d0 * 2048 + 512);
        if (d0 == 0) { p0 = __builtin_amdgcn_mfma_f32_32x32x16_bf16(b0, qr[0], cinit, 0, 0, 0); p1 = __builtin_amdgcn_mfma_f32_32x32x16_bf16(b1, qr[0], cinit, 0, 0, 0); }
        else { p0 = __builtin_amdgcn_mfma_f32_32x32x16_bf16(b0, qr[d0], p0, 0, 0, 0); p1 = __builtin_amdgcn_mfma_f32_32x32x16_bf16(b1, qr[d0], p1, 0, 0, 0); } }
}
__device__ __forceinline__ void pv(f32x16* o, int vb, bf16x8 pa0, bf16x8 pa1, bf16x8 pa2, bf16x8 pa3) {
#pragma unroll
    for (int d0 = 0; d0 < 2; ++d0) { s16x4 lo[4], hi[4];
#pragma unroll
        for (int ks = 0; ks < 4; ++ks) {
            asm volatile("ds_read_b64_tr_b16 %0,%1 offset:%c2" : "=&v"(lo[ks]) : "v"(vb), "i"(d0 * 4096 + ks * 1024) : "memory");
            asm volatile("ds_read_b64_tr_b16 %0,%1 offset:%c2" : "=&v"(hi[ks]) : "v"(vb), "i"(d0 * 4096 + ks * 1024 + 512) : "memory"); }
        asm volatile("s_waitcnt lgkmcnt(0)" ::: "memory"); SBAR();
#define PK(k) (bf16x8){lo[k][0], lo[k][1], lo[k][2], lo[k][3], hi[k][0], hi[k][1], hi[k][2], hi[k][3]}
        o[d0] = __builtin_amdgcn_mfma_f32_32x32x16_bf16(pa0, PK(0), o[d0], 0, 0, 0);
        o[d0] = __builtin_amdgcn_mfma_f32_32x32x16_bf16(pa1, PK(1), o[d0], 0, 0, 0);
        o[d0] = __builtin_amdgcn_mfma_f32_32x32x16_bf16(pa2, PK(2), o[d0], 0, 0, 0);
        o[d0] = __builtin_amdgcn_mfma_f32_32x32x16_bf16(pa3, PK(3), o[d0], 0, 0, 0);
#undef PK
    }
}
#define PKW(P, B) cvtpk_s(P[B], P[(B) + 1])
#define PACK_P(P0, P1) do { pw0 = (u32x4){PKW(P0, 0), PKW(P0, 2), PKW(P0, 4), PKW(P0, 6)}; pw1 = (u32x4){PKW(P0, 8), PKW(P0, 10), PKW(P0, 12), PKW(P0, 14)}; \
                            pw2 = (u32x4){PKW(P1, 0), PKW(P1, 2), PKW(P1, 4), PKW(P1, 6)}; pw3 = (u32x4){PKW(P1, 8), PKW(P1, 10), PKW(P1, 12), PKW(P1, 14)}; } while (0)
#define PAF(k) __builtin_bit_cast(bf16x8, pw##k)

__device__ __forceinline__ void sb_unit(int b, int h, int qb, const bf16* SQ, const bf16* __restrict__ SK, const bf16* __restrict__ SV, bf16* OB, ATT_LAS unsigned char* Lb) {
    const int tid = threadIdx.x, lane = tid & 63, r32 = lane & 31, hi = lane >> 5; const int wid = __builtin_amdgcn_readfirstlane(tid >> 6);
    const long rowbase = (long)b * SEQ; const int q0 = qb * 256;
    const bf16* Qw = SQ + (rowbase + q0 + wid * 32) * 1024 + h * 64;
    const bf16* Kh = SK + rowbase * 1024 + h * 64; const bf16* Vh = SV + rowbase * 1024 + h * 64;
    const unsigned lds0 = (unsigned)(uintptr_t)Lb;
    const bf16* ksrc = Kh + (long)lane * 1024 + wid * 8;
    const bf16* vsrc = Vh + (long)(16 * (wid & 3) + (lane >> 2)) * 1024 + (wid >> 2) * 32 + (lane & 3) * 8;
    const unsigned kdst = lds0 + wid * 1024, vdst = lds0 + 8192 + wid * 1024;
#define DMA_K(t, slot) glds16(ksrc + (long)(t) * 64 * 1024, (unsigned)__builtin_amdgcn_readfirstlane(kdst + (slot)))
#define DMA_V(t, slot) glds16(vsrc + (long)(t) * 64 * 1024, (unsigned)__builtin_amdgcn_readfirstlane(vdst + (slot)))
    const int vb0 = (int)(lds0 + 8192) + ((lane >> 4) & 1) * 32 + (lane & 3) * 8 + (4 * hi + ((lane & 15) >> 2)) * 64;
    const int NT = 4 * (qb + 1);
    DMA_K(NT - 1, 0); DMA_V(NT - 1, 0);
    bf16x8 qr[4];
#pragma unroll
    for (int d0 = 0; d0 < 4; ++d0) qr[d0] = *reinterpret_cast<const bf16x8*>(&Qw[(long)r32 * 1024 + d0 * 16 + hi * 8]);
    f32x16 o[2]; o[0] = f32x16{}; o[1] = f32x16{};
    const f32x16 zero = f32x16{};
    float R = 0.f;
    const int qrel = wid * 32 + r32;
    ATT_LAS unsigned* flg = (ATT_LAS unsigned*)(Lb + 98304);
    for (int n = 0; n < NT; ++n) {
        const int t = NT - 1 - n; const int slot = (n & 1) * 16384;
        WAIT_BAR0();
        if (n > 0) { const ATT_LAS unsigned* f = flg + ((n - 1) & 1) * 8;
            const unsigned all_done = (f[0] & f[1]) & (f[2] & f[3]) & (f[4] & f[5]) & (f[6] & f[7]);
            if (__builtin_amdgcn_readfirstlane(all_done)) break; }
        if (n + 1 < NT) { DMA_K(t - 1, slot ^ 16384); DMA_V(t - 1, slot ^ 16384); }
        const int jb = t - 4 * qb;
        const bool skip = (jb >= 0) && (64 * jb > 32 * wid + 30);
        if (!skip) {
            const bool partial = (jb >= 0) && !(64 * jb + 63 < 32 * wid);
            f32x16 p0, p1;
            qkt(p0, p1, (lds_cptr)(Lb + slot), qr, zero, r32, hi);
            const int kb = 64 * jb + 4 * hi;
            float lk0[16], lk1[16];
#pragma unroll
            for (int r = 0; r < 16; ++r) {
                { const float y = p0[r]; const float sp = fmaxf(y, 0.f) + __builtin_amdgcn_logf(1.0f + __builtin_amdgcn_exp2f(-fabsf(y)));
                  const bool v = !partial || (kb + crowc(r) < qrel); lk0[r] = v ? -sp : 0.f; p0[r] = v ? (y - sp) : -INFINITY; }
                { const float y = p1[r]; const float sp = fmaxf(y, 0.f) + __builtin_amdgcn_logf(1.0f + __builtin_amdgcn_exp2f(-fabsf(y)));
                  const bool v = !partial || (kb + 32 + crowc(r) < qrel); lk1[r] = v ? -sp : 0.f; p1[r] = v ? (y - sp) : -INFINITY; }
            }
            float G[8], PG[8], S8[8];
#pragma unroll
            for (int gi = 0; gi < 4; ++gi) { G[gi] = (lk0[4 * gi] + lk0[4 * gi + 1]) + (lk0[4 * gi + 2] + lk0[4 * gi + 3]); G[4 + gi] = (lk1[4 * gi] + lk1[4 * gi + 1]) + (lk1[4 * gi + 2] + lk1[4 * gi + 3]); }
#pragma unroll
            for (int gi = 0; gi < 8; ++gi) PG[gi] = __shfl_xor(G[gi], 32);
            S8[7] = 0.f;
#pragma unroll
            for (int gi = 6; gi >= 0; --gi) S8[gi] = S8[gi + 1] + (G[gi + 1] + PG[gi + 1]);
            const float total = S8[0] + (G[0] + PG[0]);
#pragma unroll
            for (int gi = 0; gi < 8; ++gi) {
                const float s3 = R + S8[gi] + (hi ? 0.f : PG[gi]);
                if (gi < 4) { const float s2 = s3 + lk0[4 * gi + 3], s1 = s2 + lk0[4 * gi + 2], s0 = s1 + lk0[4 * gi + 1];
                    p0[4 * gi + 3] = __builtin_amdgcn_exp2f(p0[4 * gi + 3] + s3); p0[4 * gi + 2] = __builtin_amdgcn_exp2f(p0[4 * gi + 2] + s2);
                    p0[4 * gi + 1] = __builtin_amdgcn_exp2f(p0[4 * gi + 1] + s1); p0[4 * gi] = __builtin_amdgcn_exp2f(p0[4 * gi] + s0); }
                else { const int g4 = gi - 4; const float s2 = s3 + lk1[4 * g4 + 3], s1 = s2 + lk1[4 * g4 + 2], s0 = s1 + lk1[4 * g4 + 1];
                    p1[4 * g4 + 3] = __builtin_amdgcn_exp2f(p1[4 * g4 + 3] + s3); p1[4 * g4 + 2] = __builtin_amdgcn_exp2f(p1[4 * g4 + 2] + s2);
                    p1[4 * g4 + 1] = __builtin_amdgcn_exp2f(p1[4 * g4 + 1] + s1); p1[4 * g4] = __builtin_amdgcn_exp2f(p1[4 * g4] + s0); }
            }
            R += total;
            u32x4 pw0, pw1, pw2, pw3; PACK_P(p0, p1);
            SBAR(); pv(o, vb0 + slot, PAF(0), PAF(1), PAF(2), PAF(3));
        }
        {   const bool done = !skip && __all(R < -100.0f);
            if (lane == 0) flg[(n & 1) * 8 + wid] = done ? 1u : 0u; }
    }
    bf16* Ow = OB + (rowbase + q0 + wid * 32) * 1024 + h * 64;
    {   ATT_LAS bf16* stg = (ATT_LAS bf16*)(Lb + 65536) + wid * 2048;
#pragma unroll
        for (int r = 0; r < 16; ++r) { const int orow = crowc(r) + 4 * hi;
#pragma unroll
            for (int d0 = 0; d0 < 2; ++d0) stg[orow * 64 + d0 * 32 + r32] = (bf16)f2bf(o[d0][r]); }
        asm volatile("s_waitcnt lgkmcnt(0)" ::: "memory");
#pragma unroll
        for (int i = 0; i < 4; ++i) { const int row = i * 8 + (lane >> 3), ch = lane & 7; const u32x4 v = *(const ATT_LAS u32x4*)(stg + row * 64 + ch * 8); *(u32x4*)(Ow + (long)row * 1024 + ch * 8) = v; } }
    LDS_BAR();
#undef DMA_K
#undef DMA_V
}

__device__ __forceinline__ void da_unit(int b, int h, int iu, const bf16* DQ, const bf16* __restrict__ DK, const bf16* __restrict__ DV, bf16* OA, ATT_LAS unsigned char* Lb, ATT_LAS float* TB, ATT_LAS float* wsf_all,
                                        const float* __restrict__ rel_bias, const float* __restrict__ subln, float lam) {
    const int tid = threadIdx.x, lane = tid & 63, r32 = lane & 31, hi = lane >> 5; const int wid = __builtin_amdgcn_readfirstlane(tid >> 6);
    const int qblk = wid & 3, mp = wid >> 2;
    const long rowbase = (long)b * SEQ; const int q0 = iu * 128;
    const int c = 2 * iu + (qblk >> 1);
    const int qc = 32 * (qblk & 1) + r32;
    ATT_LAS float* wsf = wsf_all + wid * 64;
    {   const int mm = tid >> 8, i = tid & 255; const int rel = i - 191;
        TB[mm * 256 + i] = (i < 255) ? rel_bias[rel_bucket(rel) * 16 + 2 * h + mm] * 1.4426950408889634f : 0.f; }
    const float bfar = rel_bias[15 * 16 + 2 * h + mp] * 1.4426950408889634f;
    const bf16* Qw = DQ + (rowbase + q0 + 32 * qblk) * 1024 + h * 128 + mp * 64;
    const unsigned lds0 = (unsigned)(uintptr_t)Lb;
    const bf16* ksrc = DK + (rowbase + lane) * 1024 + h * 128 + wid * 8;
    const bf16* vsrc = DV + (rowbase + 16 * (wid & 3) + (lane >> 2)) * 1024 + h * 128 + (wid >> 2) * 32 + (lane & 3) * 8;
    const unsigned pdst = lds0 + wid * 1024;
#define DMA_TILE(t, slot) do { const unsigned d_ = (unsigned)__builtin_amdgcn_readfirstlane(pdst + (slot)); const long to_ = (long)(t) * 64 * 1024; \
        glds16(ksrc + to_, d_); glds16(ksrc + to_ + 64, d_ + 8192); glds16(vsrc + to_, d_ + 16384); glds16(vsrc + to_ + 64, d_ + 24576); } while (0)
    const int vb0 = (int)(lds0 + 16384) + ((lane >> 4) & 1) * 32 + (lane & 3) * 8 + (4 * hi + ((lane & 15) >> 2)) * 64;
    const int NT = 2 * iu + 2;
    DMA_TILE(0, 0);
    bf16x8 qr[4];
#pragma unroll
    for (int d0 = 0; d0 < 4; ++d0) qr[d0] = *reinterpret_cast<const bf16x8*>(&Qw[(long)r32 * 1024 + d0 * 16 + hi * 8]);
    f32x16 o[4]; o[0] = f32x16{}; o[1] = f32x16{}; o[2] = f32x16{}; o[3] = f32x16{};
    float mrun = -1e30f, lsum = 0.f;
    for (int n = 0; n < NT; ++n) {
        const int t = n; const int slot = (n & 1) * 32768;
        WAIT_BAR0();
        if (n + 1 < NT) DMA_TILE(t + 1, slot ^ 32768);
        if (t <= c) {
            const bool near = (t >= c - 2);
            const float ci = near ? 0.f : bfar;
            f32x16 cinit;
#pragma unroll
            for (int r = 0; r < 16; ++r) cinit[r] = ci;
            f32x16 p0, p1;
            qkt(p0, p1, (lds_cptr)(Lb + slot + mp * 8192), qr, cinit, r32, hi);
            if (near) {
                const ATT_LAS float* tbp = TB + mp * 256 + (64 * (t - c + 2) + 63 - qc + 4 * hi);
#pragma unroll
                for (int r = 0; r < 16; ++r) { p0[r] += tbp[crowc(r)]; p1[r] += tbp[32 + crowc(r)]; }
            }
            float rm = fmaxf(p0[0], p1[0]);
#pragma unroll
            for (int r = 1; r < 16; ++r) rm = fmaxf(rm, fmaxf(p0[r], p1[r]));
            rm = fmaxf(rm, __shfl_xor(rm, 32));
            const float mnew = fmaxf(mrun, rm); const float f = __builtin_amdgcn_exp2f(mrun - mnew);
            const bool moved = __any(mnew > mrun); mrun = mnew;
            if (moved && hi == 0) wsf[r32] = f;
            float ps = 0.f;
#pragma unroll
            for (int r = 0; r < 16; ++r) { p0[r] = __builtin_amdgcn_exp2f(p0[r] - mnew); p1[r] = __builtin_amdgcn_exp2f(p1[r] - mnew); ps += p0[r] + p1[r]; }
            lsum = lsum * f + ps;
            if (moved) {
                asm volatile("s_waitcnt lgkmcnt(0)" ::: "memory");
#pragma unroll
                for (int r = 0; r < 16; ++r) { const float fr_ = wsf[crowc(r) + 4 * hi];
#pragma unroll
                    for (int d = 0; d < 4; ++d) o[d][r] *= fr_; }
            }
            u32x4 pw0, pw1, pw2, pw3; PACK_P(p0, p1);
            SBAR(); pv(o, vb0 + slot, PAF(0), PAF(1), PAF(2), PAF(3));
            SBAR(); pv(o + 2, vb0 + slot + 8192, PAF(0), PAF(1), PAF(2), PAF(3));
        }
    }
    {   const float lt = lsum + __shfl_xor(lsum, 32); float inv = 1.0f / lt; if (mp == 1) inv *= lam;
        asm volatile("s_waitcnt lgkmcnt(0)" ::: "memory");
        if (hi == 0) wsf[r32] = inv;
        asm volatile("s_waitcnt lgkmcnt(0)" ::: "memory");
#pragma unroll
        for (int r = 0; r < 16; ++r) { const float fr_ = wsf[crowc(r) + 4 * hi];
#pragma unroll
            for (int d = 0; d < 4; ++d) o[d][r] *= fr_; } }
    LDS_BAR();
    ATT_LAS float* X = (ATT_LAS float*)Lb + (size_t)qblk * (4 * 16 * 64) + lane;
    if (mp == 1) {
#pragma unroll
        for (int d = 0; d < 4; ++d)
#pragma unroll
            for (int r = 0; r < 16; ++r) X[(d * 16 + r) * 64] = o[d][r];
    }
    LDS_BAR();
    if (mp == 0) {
        float ssq[16];
#pragma unroll
        for (int r = 0; r < 16; ++r) { float s = 0.f;
#pragma unroll
            for (int d = 0; d < 4; ++d) { o[d][r] -= X[(d * 16 + r) * 64]; s += o[d][r] * o[d][r]; }
            ssq[r] = s; }
#pragma unroll
        for (int r = 0; r < 16; ++r) {
#pragma unroll
            for (int off = 1; off < 32; off <<= 1) ssq[r] += __shfl_xor(ssq[r], off);
            ssq[r] = rsqrtf(ssq[r] * (1.0f / 128.0f) + SUBLN_EPS) * (1.0f - LAMBDA_INIT); }
        ATT_LAS bf16* stg = (ATT_LAS bf16*)(Lb + 65536) + qblk * 4096;
#pragma unroll
        for (int d = 0; d < 4; ++d) { const float gsub = subln[32 * d + r32];
#pragma unroll
            for (int r = 0; r < 16; ++r) stg[(crowc(r) + 4 * hi) * 128 + 32 * d + r32] = (bf16)f2bf(o[d][r] * ssq[r] * gsub); }
        asm volatile("s_waitcnt lgkmcnt(0)" ::: "memory");
        bf16* Ow = OA + (rowbase + q0 + 32 * qblk) * 1024 + h * 128;
#pragma unroll
        for (int i = 0; i < 8; ++i) { const int row = i * 4 + (lane >> 4), ch = lane & 15; const u32x4 v = *(const ATT_LAS u32x4*)(stg + row * 128 + ch * 8); *(u32x4*)(Ow + (long)row * 1024 + ch * 8) = v; }
    }
    LDS_BAR();
#undef DMA_TILE
}
#undef PKW
#undef PACK_P
#undef PAF
#undef SBAR
#undef WAIT_BAR0
#undef LDS_BAR
}

struct Args { const float* in[19]; float* out; unsigned char* ws; int ph_lo, ph_hi, li, pad; };
constexpr int N_PHASES = 10;
__global__ void __launch_bounds__(NWAVES * 64, 2) mega_fwd(Args args) {
    extern __shared__ __attribute__((aligned(16))) unsigned char lds[];
    LAS unsigned char* const L = (LAS unsigned char*)lds;
    volatile LAS unsigned* const MISC = (volatile LAS unsigned*)(L + MISC_OFF);
    const int tid = threadIdx.x, lane = tid & 63, wave = __builtin_amdgcn_readfirstlane(tid >> 6);
    const int G = gridDim.x; const int bx = blockIdx.x; const int vcu = (G % 8 == 0) ? (bx % 8) * (G / 8) + bx / 8 : bx;
    unsigned char* const ws = args.ws;
    gu32* const ctl = (gu32*)(ws + WS_CTL);
    const float* const x = args.in[0];
    float* const out = args.out;
    bf16* const XB = (bf16*)(ws + WS_XB); bf16* const HB = (bf16*)(ws + WS_H);
    float* const RS1 = (float*)(ws + WS_CTL) + CW_RS1; float* const SS2 = (float*)(ws + WS_CTL) + CW_SS2; float* const SS3 = (float*)(ws + WS_CTL) + CW_SS3; float* const SS4 = (float*)(ws + WS_CTL) + CW_SS4;
    for (int u = tid; u < (LDS_BYTES - LDSCTL_OFF) / 4; u += NWAVES * 64) ((LAS unsigned*)(L + LDSCTL_OFF))[u] = 0u;
    __syncthreads();
    const int lo = args.ph_lo, hi = args.ph_hi;
    const bool use_bar = (hi - lo) > 1;
    XcdBarrier bar; bar.bar = (unsigned*)(ctl + CW_BAR) + args.li * XCD_BAR_WORDS; bar.x = 0; bar.st = nullptr;
    if (use_bar) bar = xcd_barrier_post((unsigned*)(ctl + CW_BAR) + args.li * XCD_BAR_WORDS, MISC + 8);
#define IN(k) (lo <= (k) && (k) < hi)
#define SEAM(k) do { if (IN(k) && IN((k) + 1)) xcd_barrier(bar); } while (0)
    const int gw = vcu * NWAVES + wave, NGW = G * NWAVES;

    if (IN(0)) for (int rep_ = 0; rep_ < ((REP_PHASE == 0) ? 2 : 1); ++rep_) {
        constexpr int I_GU = (D / 64) * (2 * FF / 64), I_DN = (FF / 64) * (D / 64), I_IN = (D / 64) * (NIN / 64), I_BR = (1024 / 64) * (D / 64), I_OUT = (D / 64) * (D / 64);
        constexpr int NITEMS = 2 * I_GU + 2 * I_DN + I_IN + 2 * I_BR + I_OUT;
        for (int it = gw; it < NITEMS; it += NGW) {
            int r = it;
            if (r < I_GU) { p0_convert_item<true>(args.in[3], D, 2 * FF, args.in[2], (bf16*)(ws + WS_WGU1), r, lane); continue; } r -= I_GU;
            if (r < I_GU) { p0_convert_item<true>(args.in[16], D, 2 * FF, args.in[15], (bf16*)(ws + WS_WGU2), r, lane); continue; } r -= I_GU;
            if (r < I_DN) { p0_convert_item<false>(args.in[4], FF, D, nullptr, (bf16*)(ws + WS_WD1), r, lane); continue; } r -= I_DN;
            if (r < I_DN) { p0_convert_item<false>(args.in[17], FF, D, nullptr, (bf16*)(ws + WS_WD2), r, lane); continue; } r -= I_DN;
            if (r < I_IN) { p0_convert_item<false>(args.in[6], D, NIN, args.in[5], (bf16*)(ws + WS_WIN), r, lane); continue; } r -= I_IN;
            if (r < I_BR) { p0_convert_item<false>(args.in[12], 1024, D, nullptr, (bf16*)(ws + WS_WA), r, lane); continue; } r -= I_BR;
            if (r < I_BR) { p0_convert_item<false>(args.in[13], 1024, D, nullptr, (bf16*)(ws + WS_WB), r, lane); continue; } r -= I_BR;
            p0_convert_item<false>(args.in[14], D, D, nullptr, (bf16*)(ws + WS_WOUT), r, lane);
        }
        for (int m = gw; m < M; m += NGW) {
            const GAS f32x4* xr = (const GAS f32x4*)(x + (size_t)m * D) + lane;
            f32x4 v[8]; float s = 0.f;
#pragma unroll
            for (int j = 0; j < 8; ++j) { v[j] = xr[64 * j]; s += (v[j].x * v[j].x + v[j].y * v[j].y) + (v[j].z * v[j].z + v[j].w * v[j].w); }
            s = wave_sum(s);
            if (lane == 0) RS1[m] = rsqrtf(s * (1.0f / D) + 1e-6f);
            GAS unsigned long long* o8 = (GAS unsigned long long*)(XB + (size_t)m * D) + lane;
#pragma unroll
            for (int j = 0; j < 8; ++j) o8[64 * j] = (unsigned long long)cvtpk(v[j].x, v[j].y) | ((unsigned long long)cvtpk(v[j].z, v[j].w) << 32);
        }
    }
    SEAM(0);
    if (IN(1)) for (int rep_ = 0; rep_ < ((REP_PHASE == 1) ? 2 : 1); ++rep_) {
        pg8::Gemm g{XB, (const bf16*)(ws + WS_WGU1), M, 2 * FF, D}; pg8::StaticOrder S; S.init(M, 2 * FF, G, bx);
        pg8::EpiSwiGLU<false> E{HB, RS1};
        pg8::gemm_phase<pg8::EpiSwiGLU<false>, pg8::StaticOrder, PG8_ALIGN, PG8_SP2>(L + RING_OFF, g, S, E);
    }
    SEAM(1);
    if (IN(2)) {
        pg8::Gemm g{HB, (const bf16*)(ws + WS_WD1), M, D, FF}; pg8::StaticOrder S; S.init(M, D, G, bx);
        pg8::EpiResid<false, false, true> E{x, nullptr, nullptr, XB, SS2, 0.5f};
        pg8::gemm_phase<pg8::EpiResid<false, false, true>, pg8::StaticOrder, PG8_ALIGN, PG8_SP2>(L + RING_OFF, g, S, E);
    }
    SEAM(2);
    if (IN(3)) {
        pg8::Gemm g{XB, (const bf16*)(ws + WS_WIN), M, 6144, D}; pg8::StaticOrder S; S.init(M, 6144, G, bx);
        pg8::EpiQKV E{(bf16*)(ws + WS_QKV), QKV_SPLIT / 2, SS2, C2};
        pg8::gemm_phase<pg8::EpiQKV, pg8::StaticOrder, PG8_ALIGN, PG8_SP2>(L + RING_OFF, g, S, E);
    }
    SEAM(3);
    if (IN(4)) for (int rep_ = 0; rep_ < ((REP_PHASE == 4) ? 2 : 1); ++rep_) {
        const bf16* q6 = (const bf16*)(ws + WS_QKV); const size_t sp = QKV_SPLIT / 2;
#ifndef ATT_NAIVE_DA
        {   const float lam = __expf(wave_sum(args.in[7][lane] * args.in[8][lane])) - __expf(wave_sum(args.in[9][lane] * args.in[10][lane])) + LAMBDA_INIT;
            LAS float* TB = (LAS float*)(L + LDSCTL_OFF + 1024); LAS float* wsf = (LAS float*)(L + LDSCTL_OFF + 4096);
            const int bh = vcu >> 3, s8 = vcu & 7;
            for (int i = 0; i < 2; ++i)
                att::da_unit(bh / DA_HEADS, bh % DA_HEADS, i == 0 ? 15 - s8 : s8, q6, q6 + sp, q6 + 2 * sp, (bf16*)(ws + WS_OA), L + RING_OFF, TB, wsf, args.in[1], args.in[11], lam);
        }
#endif
#ifndef ATT_NAIVE_SB
        {   const int bh = vcu >> 2, s4 = vcu & 3;
            for (int i = 0; i < 2; ++i)
                att::sb_unit(bh / SB_HEADS, bh % SB_HEADS, i == 0 ? 7 - s4 : s4, q6 + 3 * sp, q6 + 4 * sp, q6 + 5 * sp, (bf16*)(ws + WS_OB), L + RING_OFF);
        }
#endif
#if defined(ATT_NAIVE_DA) || defined(ATT_NAIVE_SB)
        {   LAS float* sS = (LAS float*)(L + RING_OFF) + wave * (2 * SEQ); LAS float* sQ = (LAS float*)(L + LDSCTL_OFF + 1024) + wave * 128;
            __syncthreads();
#ifdef ATT_NAIVE_DA
            const float lam = __expf(wave_sum(args.in[7][lane] * args.in[8][lane])) - __expf(wave_sum(args.in[9][lane] * args.in[10][lane])) + LAMBDA_INIT;
            for (int i = 0; i < BATCH * DA_HEADS; ++i) { const int q = (gw + 65 * i) & (SEQ - 1);
                da_row_naive(sS, sQ, i / DA_HEADS, i % DA_HEADS, q, lane, lam, q6, q6 + sp, q6 + 2 * sp, args.in[1], args.in[11], (bf16*)(ws + WS_OA)); }
#endif
#ifdef ATT_NAIVE_SB
            for (int i = 0; i < BATCH * SB_HEADS; ++i) { const int q = (gw + 65 * i) & (SEQ - 1);
                sb_row_naive(sS, sQ, i / SB_HEADS, i % SB_HEADS, q, lane, q6 + 3 * sp, q6 + 4 * sp, q6 + 5 * sp, (bf16*)(ws + WS_OB)); }
#endif
            __syncthreads();
        }
#endif
    }
    SEAM(4);
    if (IN(5)) {
        bf16* const Gt = (bf16*)(ws + WS_G); bf16* const T = (bf16*)(ws + WS_T); bf16* const MG = (bf16*)(ws + WS_MG);
        pg8::StaticOrder S; S.init(M, D, G, bx);
        { pg8::Gemm g{XB, (const bf16*)(ws + WS_WIN) + (size_t)6144 * D, M, D, D}; pg8::EpiGate E{Gt, SS2};
          pg8::gemm_phase<pg8::EpiGate, pg8::StaticOrder, PG8_ALIGN, PG8_SP2>(L + RING_OFF, g, S, E); }
        { pg8::Gemm g{(const bf16*)(ws + WS_OA), (const bf16*)(ws + WS_WA), M, D, 1024}; pg8::EpiBranch<true> E{Gt, T, MG};
          pg8::gemm_phase<pg8::EpiBranch<true>, pg8::StaticOrder, PG8_ALIGN, PG8_SP2>(L + RING_OFF, g, S, E); }
        { pg8::Gemm g{XB, (const bf16*)(ws + WS_WIN) + (size_t)8192 * D, M, D, D}; pg8::EpiGate E{Gt, SS2};
          pg8::gemm_phase<pg8::EpiGate, pg8::StaticOrder, PG8_ALIGN, PG8_SP2>(L + RING_OFF, g, S, E); }
        { pg8::Gemm g{(const bf16*)(ws + WS_OB), (const bf16*)(ws + WS_WB), M, D, 1024}; pg8::EpiBranch<false> E{Gt, T, MG};
          pg8::gemm_phase<pg8::EpiBranch<false>, pg8::StaticOrder, PG8_ALIGN, PG8_SP2>(L + RING_OFF, g, S, E); }
    }
    SEAM(5);
    if (IN(6)) {
        pg8::Gemm g{(const bf16*)(ws + WS_MG), (const bf16*)(ws + WS_WOUT), M, D, D}; pg8::StaticOrder S; S.init(M, D, G, bx);
        pg8::EpiResid<true, false, true> E{nullptr, XB, nullptr, XB, SS3, 1.0f};
        pg8::gemm_phase<pg8::EpiResid<true, false, true>, pg8::StaticOrder, PG8_ALIGN, PG8_SP2>(L + RING_OFF, g, S, E);
    }
    SEAM(6);
    if (IN(7)) for (int rep_ = 0; rep_ < ((REP_PHASE == 7) ? 2 : 1); ++rep_) {
        pg8::Gemm g{XB, (const bf16*)(ws + WS_WGU2), M, 2 * FF, D}; pg8::StaticOrder S; S.init(M, 2 * FF, G, bx);
        pg8::EpiSwiGLU<true> E{HB, SS3};
        pg8::gemm_phase<pg8::EpiSwiGLU<true>, pg8::StaticOrder, PG8_ALIGN, PG8_SP2>(L + RING_OFF, g, S, E);
    }
    SEAM(7);
    if (IN(8)) {
        pg8::Gemm g{HB, (const bf16*)(ws + WS_WD2), M, D, FF}; pg8::StaticOrder S; S.init(M, D, G, bx);
        pg8::EpiResid<true, true, false> E{nullptr, XB, out, nullptr, SS4, 0.5f};
        pg8::gemm_phase<pg8::EpiResid<true, true, false>, pg8::StaticOrder, PG8_ALIGN, PG8_SP2>(L + RING_OFF, g, S, E);
    }
    SEAM(8);
    if (IN(9)) {
        const float* gf = args.in[18];
        for (int m = gw; m < M; m += NGW) {
            GAS f32x4* xr = (GAS f32x4*)(out + (size_t)m * D) + lane; const GAS f32x4* gr = (const GAS f32x4*)gf + lane;
            const float r = rsqrtf(SS4[m] * (1.0f / D) + 1e-6f);
#pragma unroll
            for (int j = 0; j < 8; ++j) { const f32x4 v = xr[64 * j]; xr[64 * j] = v * r * gr[64 * j]; }
        }
    }
#undef IN
#undef SEAM
}

extern "C" void kernel_launch(void* const* d_in, const int* in_sizes, int n_in, void* d_out, int out_size, void* d_ws, size_t ws_size, hipStream_t stream) {
    static int grid = 0;
    if (grid == 0) {
        if (n_in != 19 || out_size != M * D || ws_size < WS_END) { fprintf(stderr, "kernel_launch: unexpected shapes (n_in %d out %d ws %zu)\n", n_in, out_size, ws_size); grid = -1; return; }
        int dev = 0, cus = 0, per_cu = 0;
        if (hipGetDevice(&dev) != hipSuccess || hipDeviceGetAttribute(&cus, hipDeviceAttributeMultiprocessorCount, dev) != hipSuccess) { grid = -1; return; }
        if (hipFuncSetAttribute((const void*)mega_fwd, hipFuncAttributeMaxDynamicSharedMemorySize, LDS_BYTES) != hipSuccess) { fprintf(stderr, "kernel_launch: hipFuncSetAttribute failed\n"); grid = -1; return; }
        if (hipOccupancyMaxActiveBlocksPerMultiprocessor(&per_cu, (const void*)mega_fwd, NWAVES * 64, LDS_BYTES) != hipSuccess || per_cu < 1) fprintf(stderr, "kernel_launch: occupancy query says %d\n", per_cu);
        (void)hipGetLastError();
        grid = cus;
    }
    if (grid < 0) return;
    (void)hipMemsetAsync((char*)d_ws + WS_CTL, 0, CTL_ZERO_BYTES, stream);
    Args a{};
    for (int i = 0; i < 19; ++i) a.in[i] = (const float*)d_in[i];
    a.out = (float*)d_out; a.ws = (unsigned char*)d_ws;
    unsigned char* ws = (unsigned char*)d_ws;
    auto mega = [&](int lo, int hi, int li) { a.ph_lo = lo; a.ph_hi = hi; a.li = li; hipLaunchKernelGGL(mega_fwd, dim3(grid), dim3(NWAVES * 64), LDS_BYTES, stream, a); };
    auto naive_attn = [&]() {
        const bf16* q6 = (const bf16*)(ws + WS_QKV); const size_t sp = QKV_SPLIT / 2;
        k_da_naive<<<BATCH * DA_HEADS * SEQ / 2, 128, 0, stream>>>(q6, q6 + sp, q6 + 2 * sp, a.in[1], a.in[7], a.in[8], a.in[9], a.in[10], a.in[11], (bf16*)(ws + WS_OA));
        k_sb_naive<<<BATCH * SB_HEADS * SEQ / 4, 256, 0, stream>>>(q6 + 3 * sp, q6 + 4 * sp, q6 + 5 * sp, (bf16*)(ws + WS_OB));
    };
#if MK_MODE == 0
    for (int p = 0; p < N_PHASES; ++p) { if (p == 4) naive_attn(); else mega(p, p + 1, 0); }
#elif MK_MODE == 1
    mega(0, 4, 0); naive_attn(); mega(5, N_PHASES, 1);
#else
    mega(0, N_PHASES, 0);
#endif
}
```
